# Optimizing an MI355X kernel written in HIP

```python
import jax, jax.numpy as jnp
from jax import lax
import numpy as np

D_MODEL = 2048
BATCH = 1
SEQ = 8192
DEPTH = 4
DEC_BATCH = 32
DEC_SEQ = 32
PAST_LEN = 2048

CHUNK = 64
N_EVEN = (DEPTH + 1) // 2
N_ODD = DEPTH // 2
FFN_DIM = 5632
POOL_WINDOWS = (2, 4, 8, 16)
N_POOL_GROUPS = 4
POOL_DIM = 1024
POOL_GROUP_DIM = POOL_DIM // N_POOL_GROUPS
POOL_HIST = max(POOL_WINDOWS) - 1
MLA_HEADS = 8
Q_LORA = 512
KV_LORA = 512
QK_NOPE = 128
QK_ROPE = 64
V_HEAD = 128
QK_HEAD = QK_NOPE + QK_ROPE
ATTN_SCALE = QK_HEAD ** -0.5
ROPE_THETA = 10000.0
Q_BLOCK = 128
GMLP_CHUNK = 128
GATE_DIM = 2048
GMLP_GROUPS = 8
GMLP_GROUP_DIM = GATE_DIM // GMLP_GROUPS
EVEN_IN = POOL_DIM + Q_LORA + KV_LORA + QK_ROPE
EVEN_MIX = POOL_DIM + MLA_HEADS * V_HEAD
EPS = 1e-6

kernel_name = "pool_mla_gmlp_macaron_stream_step"


def rmsnorm(x, g):
    xf = x.astype(jnp.float32)
    y = xf * lax.rsqrt(jnp.mean(xf * xf, axis=-1, keepdims=True) + EPS)
    return (y * g.astype(jnp.float32)).astype(x.dtype)


def swiglu(h, w_gate, w_up, w_down):
    return (jax.nn.silu(h @ w_gate) * (h @ w_up)) @ w_down


def rope_cos_sin(pos):
    inv = ROPE_THETA ** (-jnp.arange(0, QK_ROPE, 2, dtype=jnp.float32) / QK_ROPE)
    ang = pos.astype(jnp.float32)[:, None] * inv[None, :]
    return jnp.cos(ang), jnp.sin(ang)


def apply_rope(x, cos, sin):
    x1, x2 = jnp.split(x.astype(jnp.float32), 2, axis=-1)
    out = jnp.concatenate([x1 * cos - x2 * sin, x1 * sin + x2 * cos], axis=-1)
    return out.astype(x.dtype)


def multi_pool(u, hist, pos, pool_w, pool_scale):
    B, L, _ = u.shape
    ext = jnp.concatenate([hist, u], axis=1)
    cs = jnp.pad(jnp.cumsum(ext.astype(jnp.float32), axis=1), ((0, 0), (1, 0), (0, 0)))
    posf = pos.astype(jnp.float32)
    outs = []
    for g, w in enumerate(POOL_WINDOWS):
        sl = slice(g * POOL_GROUP_DIM, (g + 1) * POOL_GROUP_DIM)
        s = cs[:, POOL_HIST + 1:, sl] - cs[:, POOL_HIST + 1 - w:POOL_HIST + 1 - w + L, sl]
        cnt = jnp.minimum(jnp.float32(w), posf + 1.0)
        outs.append(s / cnt[None, :, None])
    pooled = jnp.stack(outs, axis=2) - u.reshape(B, L, N_POOL_GROUPS, POOL_GROUP_DIM).astype(jnp.float32)
    y = jnp.einsum('blgc,gcd->blgd', pooled.astype(u.dtype), pool_w).reshape(B, L, POOL_DIM)
    return y * pool_scale, ext[:, -POOL_HIST:]


def mla_block(q_nope, q_pe, k_nope, k_pe, v, q_pos, k_pos):
    s = (jnp.einsum('bqhd,bkhd->bhqk', q_nope, k_nope)
         + jnp.einsum('bqhr,bkr->bhqk', q_pe, k_pe)).astype(jnp.float32) * ATTN_SCALE
    mask = (k_pos[None, :] // CHUNK) <= (q_pos[:, None] // CHUNK)
    s = jnp.where(mask[None, None], s, jnp.finfo(jnp.float32).min)
    p = jax.nn.softmax(s, axis=-1).astype(v.dtype)
    return jnp.einsum('bhqk,bkhd->bqhd', p, v)


def mla_attention(q_nope, q_pe, k_nope, k_pe, v, q_pos, k_pos):
    B, Lq = q_nope.shape[0], q_nope.shape[1]
    if Lq <= Q_BLOCK:
        return mla_block(q_nope, q_pe, k_nope, k_pe, v, q_pos, k_pos)
    nb = Lq // Q_BLOCK
    qn = q_nope.reshape(B, nb, Q_BLOCK, MLA_HEADS, QK_NOPE).swapaxes(0, 1)
    qp = q_pe.reshape(B, nb, Q_BLOCK, MLA_HEADS, QK_ROPE).swapaxes(0, 1)
    qpos = q_pos.reshape(nb, Q_BLOCK)
    out = lax.map(lambda a: mla_block(a[0], a[1], k_nope, k_pe, v, a[2], k_pos), (qn, qp, qpos))
    return out.swapaxes(0, 1).reshape(B, Lq, MLA_HEADS, V_HEAD)


def even_mixer(h, pos, ckv_hist, kpe_hist, pool_hist, w_in, q_a_norm, kv_a_norm, w_qb, w_kvb,
               q_nope_norm, q_pe_norm, k_nope_norm, k_pe_norm, pool_w, pool_scale, w_out):
    B, L, _ = h.shape
    z = h @ w_in
    u_pool, q_a, kv_a, kpe_raw = jnp.split(z, [POOL_DIM, POOL_DIM + Q_LORA, POOL_DIM + Q_LORA + KV_LORA], axis=-1)
    pool_out, pool_state = multi_pool(u_pool, pool_hist, pos, pool_w, pool_scale)
    cos, sin = rope_cos_sin(pos)
    q = (rmsnorm(q_a, q_a_norm) @ w_qb).reshape(B, L, MLA_HEADS, QK_HEAD)
    q_nope = rmsnorm(q[..., :QK_NOPE], q_nope_norm)
    q_pe = apply_rope(rmsnorm(q[..., QK_NOPE:], q_pe_norm), cos[:, None, :], sin[:, None, :])
    ckv = rmsnorm(kv_a, kv_a_norm)
    kpe = apply_rope(rmsnorm(kpe_raw, k_pe_norm), cos, sin)
    if ckv_hist is None:
        ckv_all, kpe_all, k_pos = ckv, kpe, pos
    else:
        ckv_all = jnp.concatenate([ckv_hist, ckv], axis=1)
        kpe_all = jnp.concatenate([kpe_hist, kpe], axis=1)
        k_pos = jnp.concatenate([jnp.arange(ckv_hist.shape[1], dtype=jnp.int32), pos])
    Lk = ckv_all.shape[1]
    kv = (ckv_all @ w_kvb).reshape(B, Lk, MLA_HEADS, QK_NOPE + V_HEAD)
    k_nope = rmsnorm(kv[..., :QK_NOPE], k_nope_norm)
    v = kv[..., QK_NOPE:]
    attn = mla_attention(q_nope, q_pe, k_nope, kpe_all, v, pos, k_pos)
    mix = jnp.concatenate([pool_out, attn.reshape(B, L, MLA_HEADS * V_HEAD)], axis=-1)
    return mix @ w_out, ckv, kpe, pool_state


def odd_mixer(h, w_in, v_norm, w_s, b_s, w_out):
    B, L, _ = h.shape
    z = jax.nn.gelu(h @ w_in)
    u, v = jnp.split(z, 2, axis=-1)
    v = rmsnorm(v, v_norm)
    tri = jnp.tril(jnp.ones((GMLP_CHUNK, GMLP_CHUNK), dtype=w_s.dtype))
    ws = w_s * tri[None]
    vg = v.reshape(B, L, GMLP_GROUPS, GMLP_GROUP_DIM)
    if L >= GMLP_CHUNK:
        nc = L // GMLP_CHUNK
        vc = vg.reshape(B, nc, GMLP_CHUNK, GMLP_GROUPS, GMLP_GROUP_DIM)
        s = jnp.einsum('gij,bnjgc->bnigc', ws, vc) + b_s.T[None, None, :, :, None]
        s = s.reshape(B, L, GATE_DIM)
    else:
        s = jnp.einsum('gij,bjgc->bigc', ws[:, :L, :L], vg) + b_s[:, :L].T[None, :, :, None]
        s = s.reshape(B, L, GATE_DIM)
    return (u * s) @ w_out, v


def trunk(x, start_pos, ckv_cache, kpe_cache, pool_cache, w):
    B, L, _ = x.shape
    pos = start_pos + jnp.arange(L, dtype=jnp.int32)
    new_ckv, new_kpe, new_pool, new_v = [], [], [], []
    for layer in range(DEPTH):
        x = x + 0.5 * swiglu(rmsnorm(x, w['norm_ffn1'][layer]), w['ffn1_w_gate'][layer],
                             w['ffn1_w_up'][layer], w['ffn1_w_down'][layer])
        h = rmsnorm(x, w['norm_mix'][layer])
        if layer % 2 == 0:
            e = layer // 2
            if ckv_cache is None:
                ckv_h, kpe_h = None, None
                pool_h = jnp.zeros((B, POOL_HIST, POOL_DIM), x.dtype)
            else:
                ckv_h, kpe_h, pool_h = ckv_cache[e], kpe_cache[e], pool_cache[e]
            m, ckv, kpe, pst = even_mixer(
                h, pos, ckv_h, kpe_h, pool_h, w['ev_w_in'][e], w['ev_q_a_norm'][e], w['ev_kv_a_norm'][e],
                w['ev_w_qb'][e], w['ev_w_kvb'][e], w['ev_q_nope_norm'][e], w['ev_q_pe_norm'][e],
                w['ev_k_nope_norm'][e], w['ev_k_pe_norm'][e], w['ev_pool_w'][e], w['ev_pool_scale'][e],
                w['ev_w_out'][e])
            new_ckv.append(ckv)
            new_kpe.append(kpe)
            new_pool.append(pst)
        else:
            o = layer // 2
            m, v = odd_mixer(h, w['od_w_in'][o], w['od_v_norm'][o], w['od_w_s'][o], w['od_b_s'][o], w['od_w_out'][o])
            new_v.append(v)
        x = x + m
        x = x + 0.5 * swiglu(rmsnorm(x, w['norm_ffn2'][layer]), w['ffn2_w_gate'][layer],
                             w['ffn2_w_up'][layer], w['ffn2_w_down'][layer])
    return x, jnp.stack(new_ckv), jnp.stack(new_kpe), jnp.stack(new_pool), jnp.stack(new_v)


def setup_inputs(seed: int = 0) -> dict:
    key = jax.random.key(seed)
    ks = jax.random.split(key, 32)
    f32 = jnp.float32

    def nrm(k, shape, scale=1.0):
        return jax.random.normal(k, shape, f32) * scale

    def gain(k, shape):
        return 1.0 + 0.02 * jax.random.normal(k, shape, f32)

    return {
        "x_prompt": nrm(ks[0], (BATCH, SEQ, D_MODEL)),
        "x_sample": nrm(ks[1], (DEC_BATCH, DEC_SEQ, D_MODEL)),
        "cache_mla_ckv": nrm(ks[2], (N_EVEN, DEC_BATCH, PAST_LEN, KV_LORA)),
        "cache_mla_kpe": nrm(ks[3], (N_EVEN, DEC_BATCH, PAST_LEN, QK_ROPE)),
        "state_pool": nrm(ks[4], (N_EVEN, DEC_BATCH, POOL_HIST, POOL_DIM)),
        "norm_ffn1": gain(ks[5], (DEPTH, D_MODEL)),
        "norm_mix": gain(ks[6], (DEPTH, D_MODEL)),
        "norm_ffn2": gain(ks[7], (DEPTH, D_MODEL)),
        "ffn1_w_gate": nrm(ks[8], (DEPTH, D_MODEL, FFN_DIM), D_MODEL ** -0.5),
        "ffn1_w_up": nrm(ks[9], (DEPTH, D_MODEL, FFN_DIM), D_MODEL ** -0.5),
        "ffn1_w_down": nrm(ks[10], (DEPTH, FFN_DIM, D_MODEL), FFN_DIM ** -0.5),
        "ffn2_w_gate": nrm(ks[11], (DEPTH, D_MODEL, FFN_DIM), D_MODEL ** -0.5),
        "ffn2_w_up": nrm(ks[12], (DEPTH, D_MODEL, FFN_DIM), D_MODEL ** -0.5),
        "ffn2_w_down": nrm(ks[13], (DEPTH, FFN_DIM, D_MODEL), FFN_DIM ** -0.5),
        "ev_w_in": nrm(ks[14], (N_EVEN, D_MODEL, EVEN_IN), D_MODEL ** -0.5),
        "ev_q_a_norm": gain(ks[15], (N_EVEN, Q_LORA)),
        "ev_kv_a_norm": gain(ks[16], (N_EVEN, KV_LORA)),
        "ev_w_qb": nrm(ks[17], (N_EVEN, Q_LORA, MLA_HEADS * QK_HEAD), Q_LORA ** -0.5),
        "ev_w_kvb": nrm(ks[18], (N_EVEN, KV_LORA, MLA_HEADS * (QK_NOPE + V_HEAD)), KV_LORA ** -0.5),
        "ev_q_nope_norm": gain(ks[19], (N_EVEN, QK_NOPE)),
        "ev_q_pe_norm": gain(ks[20], (N_EVEN, QK_ROPE)),
        "ev_k_nope_norm": gain(ks[21], (N_EVEN, QK_NOPE)),
        "ev_k_pe_norm": gain(ks[22], (N_EVEN, QK_ROPE)),
        "ev_pool_w": nrm(ks[23], (N_EVEN, N_POOL_GROUPS, POOL_GROUP_DIM, POOL_GROUP_DIM), POOL_GROUP_DIM ** -0.5),
        "ev_pool_scale": gain(ks[24], (N_EVEN, POOL_DIM)),
        "ev_w_out": nrm(ks[25], (N_EVEN, EVEN_MIX, D_MODEL), EVEN_MIX ** -0.5),
        "od_w_in": nrm(ks[26], (N_ODD, D_MODEL, 2 * GATE_DIM), D_MODEL ** -0.5),
        "od_v_norm": gain(ks[27], (N_ODD, GATE_DIM)),
        "od_w_s": nrm(ks[28], (N_ODD, GMLP_GROUPS, GMLP_CHUNK, GMLP_CHUNK), GMLP_CHUNK ** -0.5),
        "od_b_s": 1.0 + 0.1 * jax.random.normal(ks[29], (N_ODD, GMLP_GROUPS, GMLP_CHUNK), f32),
        "od_w_out": nrm(ks[30], (N_ODD, GATE_DIM, D_MODEL), GATE_DIM ** -0.5),
    }


def reference(x_prompt, x_sample, cache_mla_ckv, cache_mla_kpe, state_pool,
              norm_ffn1, norm_mix, norm_ffn2,
              ffn1_w_gate, ffn1_w_up, ffn1_w_down, ffn2_w_gate, ffn2_w_up, ffn2_w_down,
              ev_w_in, ev_q_a_norm, ev_kv_a_norm, ev_w_qb, ev_w_kvb,
              ev_q_nope_norm, ev_q_pe_norm, ev_k_nope_norm, ev_k_pe_norm,
              ev_pool_w, ev_pool_scale, ev_w_out,
              od_w_in, od_v_norm, od_w_s, od_b_s, od_w_out):
    w = {
        'norm_ffn1': norm_ffn1, 'norm_mix': norm_mix, 'norm_ffn2': norm_ffn2,
        'ffn1_w_gate': ffn1_w_gate, 'ffn1_w_up': ffn1_w_up, 'ffn1_w_down': ffn1_w_down,
        'ffn2_w_gate': ffn2_w_gate, 'ffn2_w_up': ffn2_w_up, 'ffn2_w_down': ffn2_w_down,
        'ev_w_in': ev_w_in, 'ev_q_a_norm': ev_q_a_norm, 'ev_kv_a_norm': ev_kv_a_norm,
        'ev_w_qb': ev_w_qb, 'ev_w_kvb': ev_w_kvb,
        'ev_q_nope_norm': ev_q_nope_norm, 'ev_q_pe_norm': ev_q_pe_norm,
        'ev_k_nope_norm': ev_k_nope_norm, 'ev_k_pe_norm': ev_k_pe_norm,
        'ev_pool_w': ev_pool_w, 'ev_pool_scale': ev_pool_scale, 'ev_w_out': ev_w_out,
        'od_w_in': od_w_in, 'od_v_norm': od_v_norm, 'od_w_s': od_w_s, 'od_b_s': od_b_s, 'od_w_out': od_w_out,
    }
    y_prompt, new_ckv_prompt, new_kpe_prompt, new_pool_prompt, _ = trunk(x_prompt, 0, None, None, None, w)
    y_sample, new_ckv_sample, new_kpe_sample, new_pool_sample, new_v_sample = trunk(
        x_sample, PAST_LEN, cache_mla_ckv, cache_mla_kpe, state_pool, w)
    return (y_prompt, y_sample, new_ckv_prompt, new_kpe_prompt, new_pool_prompt,
            new_ckv_sample, new_kpe_sample, new_pool_sample, new_v_sample)
```

```cpp
#include <hip/hip_runtime.h>
#include <cstdio>
#include <cstdint>

#ifndef MK_PER_STEP
#define MK_PER_STEP 0
#endif
#ifndef PRO_MASK
#define PRO_MASK 0xffff
#endif
#ifndef EN_PRO
#define EN_PRO 1
#define EN_FFN 1
#define EN_EVG 1
#define EN_EVMID 1
#define EN_ATTN 1
#define EN_ODDG 1
#define EN_ODDMID 1
#define EN_GATE 1
#endif

#define GAS __attribute__((address_space(1)))
#define LAS __attribute__((address_space(3)))
typedef unsigned short bf16_t;
typedef short bf16x8 __attribute__((ext_vector_type(8)));
typedef short s16x4 __attribute__((ext_vector_type(4)));
typedef float f32x4 __attribute__((ext_vector_type(4)));
typedef float f32x2 __attribute__((ext_vector_type(2)));
typedef float f32x16 __attribute__((ext_vector_type(16)));
typedef unsigned u32x4 __attribute__((ext_vector_type(4)));
typedef unsigned u32x2 __attribute__((ext_vector_type(2)));

constexpr int DM = 2048, SEQ = 8192, DEPTH = 4, DB = 32, DS = 32, PAST = 2048, FF = 5632;
constexpr int MP = SEQ, MS = DB * DS, M = MP + MS;
constexpr int LKS = PAST + DS, MKS = DB * LKS;
constexpr int POOLD = 1024, QL = 512, KVL = 512, ROPE = 64, NOPE = 128, VH = 128, QKH = 192, NH = 8;
constexpr int EVIN = 2112, EVINP = 2304, GATE = 2048;
constexpr float EPS = 1e-6f;
constexpr float ATTN_C = 0.07216878364870322f * 1.4426950408889634f;

constexpr size_t O_YP = 0, O_YS = 16777216, O_CKVP = 18874368, O_KPEP = 27262976, O_POOLP = 28311552, O_CKVS = 28342272, O_KPES = 29390848, O_POOLS = 29521920, O_VS = 30504960, O_END = 34699264;

constexpr size_t al256(size_t x) { return (x + 255) / 256 * 256; }
constexpr size_t WS_CTL = 0, CTL_BYTES = 1u << 20;
constexpr size_t WS_TAB = WS_CTL + CTL_BYTES;
constexpr size_t WS_WGU = WS_TAB + (size_t)M * 64 * 4;
constexpr size_t SZ_WGU = (size_t)2 * FF * DM * 2;
constexpr size_t WS_WD = WS_WGU + 8 * SZ_WGU;
constexpr size_t SZ_WD = (size_t)DM * FF * 2;
constexpr size_t WS_EWIN = WS_WD + 8 * SZ_WD;
constexpr size_t SZ_EWIN = (size_t)EVINP * DM * 2;
constexpr size_t WS_EWQB = WS_EWIN + 2 * SZ_EWIN;
constexpr size_t SZ_EWQB = (size_t)1536 * 512 * 2;
constexpr size_t WS_EWKVB = WS_EWQB + 2 * SZ_EWQB;
constexpr size_t SZ_EWKVB = (size_t)2048 * 512 * 2;
constexpr size_t WS_EPOOLW = WS_EWKVB + 2 * SZ_EWKVB;
constexpr size_t SZ_EPOOLW = (size_t)1024 * 256 * 2;
constexpr size_t WS_EWOUT = WS_EPOOLW + 2 * SZ_EPOOLW;
constexpr size_t SZ_SQ = (size_t)2048 * 2048 * 2;
constexpr size_t WS_OWIN = WS_EWOUT + 2 * SZ_SQ;
constexpr size_t SZ_OWIN = (size_t)4096 * 2048 * 2;
constexpr size_t WS_OWS = WS_OWIN + 2 * SZ_OWIN;
constexpr size_t SZ_OWS = (size_t)8 * 128 * 128 * 2;
constexpr size_t WS_OWOUT = WS_OWS + 2 * SZ_OWS;
constexpr size_t WS_H = WS_OWOUT + 2 * SZ_SQ;
constexpr size_t WS_BIG = WS_H + (size_t)M * DM * 2;
constexpr size_t SZ_BIG = (size_t)MKS * 2048 * 2;
constexpr size_t WS_ACT = WS_BIG, WS_Z = WS_BIG + (size_t)M * FF * 2;
static_assert(WS_Z + (size_t)M * EVINP * 4 <= WS_BIG + SZ_BIG, "overlay");
constexpr size_t WS_POOLED = WS_BIG + SZ_BIG;
constexpr size_t WS_QAN = WS_POOLED + (size_t)M * 1024 * 2;
constexpr size_t WS_Q = WS_QAN + (size_t)M * 512 * 2;
constexpr size_t WS_CKVP = WS_Q + (size_t)M * 1536 * 2;
constexpr size_t WS_KPEP = WS_CKVP + (size_t)MP * 512 * 2;
constexpr size_t WS_CKVS = WS_KPEP + (size_t)MP * 64 * 2;
constexpr size_t SZ_CKVS = (size_t)MKS * 512 * 2;
constexpr size_t WS_KPES = WS_CKVS + 2 * SZ_CKVS;
constexpr size_t SZ_KPES = (size_t)MKS * 64 * 2;
constexpr size_t WS_KVP = WS_KPES + 2 * SZ_KPES;
constexpr size_t WS_MIX = WS_KVP + (size_t)MP * 2048 * 2;
constexpr size_t WS_VN = WS_MIX + (size_t)M * 2048 * 2;
constexpr size_t WS_US = WS_VN + (size_t)M * 2048 * 2;
constexpr size_t WS_PART = WS_US + (size_t)M * 2048 * 2;
constexpr size_t WS_XB = WS_PART + (size_t)8 * 1024 * 2048 * 4;
constexpr size_t WS_END = WS_XB + (size_t)M * DM * 2;

constexpr int CW_BAR = 4096, CW_EVT = 16384;

constexpr int RING_BYTES = 131072, AUX_OFF = RING_BYTES, MISC_OFF = AUX_OFF + 8192, LDS_BYTES = 147456;
constexpr int NWAVES = 8, NTHR = 512;

#define LDS_WAIT() asm volatile("s_waitcnt lgkmcnt(0)" ::: "memory")
#define VM_WAIT() asm volatile("s_waitcnt vmcnt(0)" ::: "memory")
#define SBAR() __builtin_amdgcn_sched_barrier(0)

__device__ __forceinline__ unsigned cvt_pk_bf16(float lo, float hi) { unsigned r; asm volatile("v_cvt_pk_bf16_f32 %0, %1, %2" : "=v"(r) : "v"(lo), "v"(hi)); return r; }
__device__ __forceinline__ float bflo(unsigned w) { return __uint_as_float(w << 16); }
__device__ __forceinline__ float bfhi(unsigned w) { return __uint_as_float(w & 0xffff0000u); }
__device__ __forceinline__ float bf1(short s) { return __uint_as_float(((unsigned)(unsigned short)s) << 16); }
__device__ __forceinline__ bf16_t f2bf(float f) { return (bf16_t)(cvt_pk_bf16(f, 0.f) & 0xffffu); }
template <int CTRL> __device__ __forceinline__ float dpp_f(float v) { return __builtin_bit_cast(float, __builtin_amdgcn_update_dpp(0, __builtin_bit_cast(int, v), CTRL, 0xf, 0xf, true)); }
__device__ __forceinline__ float xor32_sum(float v) { auto r = __builtin_amdgcn_permlane32_swap(__float_as_uint(v), __float_as_uint(v), false, false); return __uint_as_float(r[0]) + __uint_as_float(r[1]); }
__device__ __forceinline__ float xor32_max(float v) { auto r = __builtin_amdgcn_permlane32_swap(__float_as_uint(v), __float_as_uint(v), false, false); return fmaxf(__uint_as_float(r[0]), __uint_as_float(r[1])); }
__device__ __forceinline__ float xor32_other(float v, int lane) { auto r = __builtin_amdgcn_permlane32_swap(__float_as_uint(v), __float_as_uint(v), false, false); return __uint_as_float(lane < 32 ? r[1] : r[0]); }
__device__ __forceinline__ float sum16(float v) {
    v += dpp_f<0xB1>(v);
    v += dpp_f<0x4E>(v);
    v += dpp_f<0x141>(v);
    v += dpp_f<0x140>(v);
    return v;
}
__device__ __forceinline__ float wave_sum(float v) {
    v = sum16(v);
    { auto r = __builtin_amdgcn_permlane16_swap(__float_as_uint(v), __float_as_uint(v), false, false); v = __uint_as_float(r[0]) + __uint_as_float(r[1]); }
    return xor32_sum(v);
}
__device__ __forceinline__ float rsq(float x) { return 1.0f / sqrtf(x); }
__device__ __forceinline__ bf16x8 pack8(const float* v) { u32x4 w; w.x = cvt_pk_bf16(v[0], v[1]); w.y = cvt_pk_bf16(v[2], v[3]); w.z = cvt_pk_bf16(v[4], v[5]); w.w = cvt_pk_bf16(v[6], v[7]); return __builtin_bit_cast(bf16x8, w); }

struct Gate { unsigned* evt; unsigned need; unsigned* tmo; volatile LAS unsigned* st; int tg, pm0; };
__device__ __forceinline__ void evt_arrive(unsigned* e, unsigned* ex, unsigned nloc) {
    asm volatile("s_waitcnt vmcnt(0)" ::: "memory");
    __syncthreads();
    if (threadIdx.x == 0) {
        bool pub = true;
        if (ex) { const unsigned old = __hip_atomic_fetch_add(ex, 1u, __ATOMIC_RELAXED, __HIP_MEMORY_SCOPE_AGENT); pub = (old + 1u == nloc); }
        if (pub) { __builtin_amdgcn_fence(__ATOMIC_RELEASE, "agent"); asm volatile("s_waitcnt vmcnt(0)" ::: "memory");
            (void)__hip_atomic_fetch_add(e, 1u, __ATOMIC_RELAXED, __HIP_MEMORY_SCOPE_AGENT); }
    }
}
__device__ __forceinline__ void evt_wait_one(const Gate& g) {
    const unsigned need = g.st ? g.st[1] : g.need;
    unsigned sp = 0;
    while (__hip_atomic_load(g.evt, __ATOMIC_RELAXED, __HIP_MEMORY_SCOPE_AGENT) < need) { __builtin_amdgcn_s_sleep(1);
        if ((++sp & 255u) == 0u) { if (__hip_atomic_load(g.tmo, __ATOMIC_RELAXED, __HIP_MEMORY_SCOPE_AGENT)) break; if (sp > (1u << 18)) { atomicAdd(g.tmo, 1u); break; } } }
    __builtin_amdgcn_fence(__ATOMIC_ACQUIRE, "agent");
    asm volatile("s_waitcnt vmcnt(0)" ::: "memory");
}

namespace pg8 {
constexpr int BM = 256, BK = 64, HALF = 128, HTB = HALF * BK * 2, STAGE_BYTES = 8 * HTB, NXCD = 8, WGM = 8;
__host__ __device__ __forceinline__ int lds_byte(int r, int c) { const int st = (r >> 4) * 2 + (c >> 5), rr = r & 15, cc = c & 31, ob = rr * 64 + cc * 2; return st * 1024 + (ob ^ (((ob >> 9) & 1) << 5)); }
__host__ __device__ __forceinline__ void stage_rc(int b, int& R, int& C) { const int st = b / 1024, sb = b % 1024, swz = sb ^ (((sb >> 9) & 1) << 5); R = (st >> 1) * 16 + swz / 64; C = (st & 1) * 32 + (swz % 64) / 2; }
__host__ __device__ __forceinline__ int perm32(int rho) { const int n = rho >> 4, i = rho & 15; return 8 * (i >> 2) + 4 * n + (i & 3); }
struct Unit { int pm, pn, kt0, nkt; };
struct Gemm { const bf16_t* A; const bf16_t* Bt; int M, N, K, lda, ldb, apn; };
struct StaticOrder {
    int nM, nN, nwg, G, c, ntk;
    __host__ __device__ void init(int M_, int N_, int G_, int c_, int K_) { nM = M_ / BM; nN = N_ / BM; nwg = nM * nN; G = G_; c = c_; ntk = K_ / BK; }
    __host__ __device__ bool next(int i, Unit& u) const {
        u.kt0 = 0; u.nkt = ntk;
        const long L = (long)i * G + c; if (L >= nwg) return false;
        int wgid = (int)L; { const int q = nwg / NXCD, r = nwg % NXCD, xcd = wgid % NXCD, off = wgid / NXCD; wgid = (xcd < r ? xcd * (q + 1) : r * (q + 1) + (xcd - r) * q) + off; }
        const int nig = WGM * nN, gid = wgid / nig, fm = gid * WGM, gsz = (nM - fm) < WGM ? (nM - fm) : WGM;
        u.pm = fm + ((wgid % nig) % gsz); u.pn = (wgid % nig) / gsz; return true;
    }
    __device__ __forceinline__ void a_ready(const Unit&) const {}
    __device__ __forceinline__ void done(const Unit&) const {}
};
struct SplitOrder {
    StaticOrder so; int c;
    __host__ __device__ void init(int N_, int G_, int c_, int K_) { so.init(8192, N_, G_, c_, K_); c = c_; }
    __host__ __device__ bool next(int i, Unit& u) const {
        if (i == 0) return so.next(0, u);
        if (i > 1) return false;
        const int sub = c & 7, tile = c >> 3; u.pm = 32 + (tile >> 3); u.pn = tile & 7;
        const int b0 = ((so.ntk * sub) / 8 + 1) & ~1, b1 = ((so.ntk * (sub + 1)) / 8 + 1) & ~1; u.kt0 = b0; u.nkt = b1 - b0; return true;
    }
    __device__ __forceinline__ void a_ready(const Unit&) const {}
    __device__ __forceinline__ void done(const Unit&) const {}
};

__device__ __forceinline__ void rl_fetch(const float* R, LAS float* RL, const Unit& u, int wid, int lane, int par) {
    if (wid < 4) __builtin_amdgcn_global_load_lds((const unsigned*)(R + u.pm * BM + wid * 64 + lane), (LAS unsigned*)(RL + par * 256 + wid * 64), 4, 0, 0);
}
struct EpiF32 {
    static constexpr bool PERM = false;
    float* C; int ldc; const float* R; LAS float* RL;
    __device__ __forceinline__ void prefetch(const Unit& u, int wid, int lane, int par) const { rl_fetch(R, RL, u, wid, lane, par); }
    __device__ __forceinline__ void operator()(const f32x4 (&acc)[2][2][4][2], const Unit& u, int wr, int wc, int fr, int fq, int par) const {
        const int row0 = u.pm * BM + wr * 64 + fr, col0 = u.pn * BM + wc * 32 + 4 * fq;
        float rr[2][4];
#pragma unroll
        for (int ai = 0; ai < 2; ++ai)
#pragma unroll
            for (int m = 0; m < 4; ++m) rr[ai][m] = RL[par * 256 + wr * 64 + fr + ai * HALF + m * 16];
        __builtin_amdgcn_sched_barrier(0);
#pragma unroll
        for (int ai = 0; ai < 2; ++ai)
#pragma unroll
            for (int m = 0; m < 4; ++m) { float* rowp = C + (size_t)(row0 + ai * HALF + m * 16) * ldc + col0; const float r = rr[ai][m];
#pragma unroll
                for (int bj = 0; bj < 2; ++bj)
#pragma unroll
                    for (int n = 0; n < 2; ++n) *(f32x4*)(rowp + bj * HALF + n * 16) = acc[ai][bj][m][n] * r; }
    }
};
struct EpiResid {
    static constexpr bool PERM = true;
    bf16_t* XB; int ldc; float scale; bf16_t* P; int ntk; float* Y;
    __device__ __forceinline__ void prefetch(const Unit&, int, int, int) const {}
    float* SSP;
    __device__ __forceinline__ void operator()(const f32x4 (&acc)[2][2][4][2], const Unit& u, int wr, int wc, int fr, int fq, int par) const {
        const int row0 = u.pm * BM + wr * 64 + fr, col0 = u.pn * BM + wc * 32 + 8 * fq;
        if (u.nkt != ntk) {
            bf16_t* Pb = P + (size_t)((u.kt0 * 8) / ntk) * (1024 * 2048) + (size_t)(row0 - 8192) * 2048 + col0;
#pragma unroll
            for (int ai = 0; ai < 2; ++ai)
#pragma unroll
                for (int m = 0; m < 4; ++m)
#pragma unroll
                    for (int bj = 0; bj < 2; ++bj) { const f32x4 t0 = acc[ai][bj][m][0], t1 = acc[ai][bj][m][1]; float v[8] = {t0.x, t0.y, t0.z, t0.w, t1.x, t1.y, t1.z, t1.w};
                        *(bf16x8*)(Pb + (size_t)(ai * HALF + m * 16) * 2048 + bj * HALF) = pack8(v); }
            return;
        }
        u32x4 b[2][4][2];
#pragma unroll
        for (int ai = 0; ai < 2; ++ai)
#pragma unroll
            for (int m = 0; m < 4; ++m)
#pragma unroll
                for (int bj = 0; bj < 2; ++bj) b[ai][m][bj] = *(const u32x4*)(XB + (size_t)(row0 + ai * HALF + m * 16) * ldc + col0 + bj * HALF);
#pragma unroll
        for (int ai = 0; ai < 2; ++ai)
#pragma unroll
            for (int m = 0; m < 4; ++m) { float ss = 0.f;
#pragma unroll
                for (int bj = 0; bj < 2; ++bj) { const u32x4 w = b[ai][m][bj]; const f32x4 t0 = acc[ai][bj][m][0], t1 = acc[ai][bj][m][1];
                    float v[8] = {bflo(w.x) + t0.x * scale, bfhi(w.x) + t0.y * scale, bflo(w.y) + t0.z * scale, bfhi(w.y) + t0.w * scale, bflo(w.z) + t1.x * scale, bfhi(w.z) + t1.y * scale, bflo(w.w) + t1.z * scale, bfhi(w.w) + t1.w * scale};
                    if (Y) { float* yp = Y + (size_t)(row0 + ai * HALF + m * 16) * ldc + col0 + bj * HALF; *(f32x4*)yp = (f32x4){v[0], v[1], v[2], v[3]}; *(f32x4*)(yp + 4) = (f32x4){v[4], v[5], v[6], v[7]}; }
                    else { const bf16x8 o8 = pack8(v); *(bf16x8*)(XB + (size_t)(row0 + ai * HALF + m * 16) * ldc + col0 + bj * HALF) = o8;
                        const u32x4 r4 = __builtin_bit_cast(u32x4, o8);
                        ss += (bflo(r4.x) * bflo(r4.x) + bfhi(r4.x) * bfhi(r4.x)) + (bflo(r4.y) * bflo(r4.y) + bfhi(r4.y) * bfhi(r4.y)) + (bflo(r4.z) * bflo(r4.z) + bfhi(r4.z) * bfhi(r4.z)) + (bflo(r4.w) * bflo(r4.w) + bfhi(r4.w) * bfhi(r4.w)); } }
                if (!Y) {
                    { auto r = __builtin_amdgcn_permlane16_swap(__float_as_uint(ss), __float_as_uint(ss), false, false); ss = __uint_as_float(r[0]) + __uint_as_float(r[1]); }
                    { auto r = __builtin_amdgcn_permlane32_swap(__float_as_uint(ss), __float_as_uint(ss), false, false); ss = __uint_as_float(r[0]) + __uint_as_float(r[1]); }
                    if (fq == 0) SSP[(size_t)(row0 + ai * HALF + m * 16) * 32 + u.pn * 4 + wc] = ss; } }
    }
};
struct EpiSwiGLU {
    static constexpr bool PERM = true;
    bf16_t* O; int ldc; const float* R; LAS float* RL;
    __device__ __forceinline__ void prefetch(const Unit& u, int wid, int lane, int par) const { rl_fetch(R, RL, u, wid, lane, par); }
    __device__ __forceinline__ void operator()(const f32x4 (&acc)[2][2][4][2], const Unit& u, int wr, int wc, int fr, int fq, int par) const {
        const int row0 = u.pm * BM + wr * 64 + fr, col0 = u.pn * HALF + wc * 32 + 8 * fq;
        float rr[2][4];
#pragma unroll
        for (int ai = 0; ai < 2; ++ai)
#pragma unroll
            for (int m = 0; m < 4; ++m) rr[ai][m] = RL[par * 256 + wr * 64 + fr + ai * HALF + m * 16];
        __builtin_amdgcn_sched_barrier(0);
#pragma unroll
        for (int ai = 0; ai < 2; ++ai)
#pragma unroll
            for (int m = 0; m < 4; ++m) {
                float v[8]; const float r = rr[ai][m];
                const f32x2 rc = {-1.4426950408889634f * r, -1.4426950408889634f * r}, r2 = {r * r, r * r};
#pragma unroll
                for (int n = 0; n < 2; ++n)
#pragma unroll
                    for (int h = 0; h < 2; ++h) { const f32x2 g2 = {acc[ai][0][m][n][2 * h], acc[ai][0][m][n][2 * h + 1]}, u2 = {acc[ai][1][m][n][2 * h], acc[ai][1][m][n][2 * h + 1]};
                        const f32x2 ex = g2 * rc; const f32x2 d = (f32x2){__builtin_amdgcn_exp2f(ex.x), __builtin_amdgcn_exp2f(ex.y)} + (f32x2){1.0f, 1.0f};
                        const f32x2 o = ((g2 * u2) * r2) * (f32x2){__builtin_amdgcn_rcpf(d.x), __builtin_amdgcn_rcpf(d.y)};
                        v[n * 4 + 2 * h] = o.x; v[n * 4 + 2 * h + 1] = o.y; }
                *(bf16x8*)(O + (size_t)(row0 + ai * HALF + m * 16) * ldc + col0) = pack8(v); }
    }
};
template <int ACT  > struct EpiBf16 {
    static constexpr bool PERM = true;
    bf16_t* O; int ldc; int col_off; const float* cscale; const float* R; LAS float* RL;
    float* SSV;
    __device__ __forceinline__ void prefetch(const Unit& u, int wid, int lane, int par) const { if (R) rl_fetch(R, RL, u, wid, lane, par); }
    __device__ __forceinline__ void operator()(const f32x4 (&acc)[2][2][4][2], const Unit& u, int wr, int wc, int fr, int fq, int par) const {
        const int row0 = u.pm * BM + wr * 64 + fr, col0 = u.pn * BM + wc * 32 + 8 * fq;
        f32x4 sv[2][2];
#pragma unroll
        for (int bj = 0; bj < 2; ++bj)
#pragma unroll
            for (int n = 0; n < 2; ++n) sv[bj][n] = cscale ? *(const f32x4*)(cscale + col0 + bj * HALF + 4 * n) : (f32x4){1.f, 1.f, 1.f, 1.f};
        float rr[2][4];
#pragma unroll
        for (int ai = 0; ai < 2; ++ai)
#pragma unroll
            for (int m = 0; m < 4; ++m) rr[ai][m] = R ? RL[par * 256 + wr * 64 + fr + ai * HALF + m * 16] : 1.f;
        __builtin_amdgcn_sched_barrier(0);
#pragma unroll
        for (int ai = 0; ai < 2; ++ai)
#pragma unroll
            for (int m = 0; m < 4; ++m) { bf16_t* rowp = O + (size_t)(row0 + ai * HALF + m * 16) * ldc + col_off + col0; const float rs = rr[ai][m]; float ss = 0.f;
#pragma unroll
                for (int bj = 0; bj < 2; ++bj) {
                    float v[8];
#pragma unroll
                    for (int n = 0; n < 2; ++n)
#pragma unroll
                        for (int e = 0; e < 4; ++e) { float x = acc[ai][bj][m][n][e] * rs;
                            if (ACT == 1) { const float t = 0.7978845608028654f * (x + 0.044715f * x * x * x);
                                x = x * __builtin_amdgcn_rcpf(1.0f + __builtin_amdgcn_exp2f(-2.8853900817779268f * t)); }
                            else x *= sv[bj][n][e];
                            v[n * 4 + e] = x; }
                    const bf16x8 o8 = pack8(v); *(bf16x8*)(rowp + bj * HALF) = o8;
                    if (ACT == 1) { const u32x4 r4 = __builtin_bit_cast(u32x4, o8);
                        ss += (bflo(r4.x) * bflo(r4.x) + bfhi(r4.x) * bfhi(r4.x)) + (bflo(r4.y) * bflo(r4.y) + bfhi(r4.y) * bfhi(r4.y)) + (bflo(r4.z) * bflo(r4.z) + bfhi(r4.z) * bfhi(r4.z)) + (bflo(r4.w) * bflo(r4.w) + bfhi(r4.w) * bfhi(r4.w)); } }
                if (ACT == 1 && SSV && u.pn >= 8) {
                    { auto r = __builtin_amdgcn_permlane16_swap(__float_as_uint(ss), __float_as_uint(ss), false, false); ss = __uint_as_float(r[0]) + __uint_as_float(r[1]); }
                    { auto r = __builtin_amdgcn_permlane32_swap(__float_as_uint(ss), __float_as_uint(ss), false, false); ss = __uint_as_float(r[0]) + __uint_as_float(r[1]); }
                    if (fq == 0) SSV[(size_t)(row0 + ai * HALF + m * 16) * 32 + (u.pn - 8) * 4 + wc] = ss; } }
    }
};

struct EpiKV {
    static constexpr bool PERM = true;
    bf16_t* O; int ldc; const float* gain; LAS float* xs;
    __device__ __forceinline__ void prefetch(const Unit&, int, int, int) const {}
    __device__ __forceinline__ void operator()(const f32x4 (&acc)[2][2][4][2], const Unit& u, int wr, int wc, int fr, int fq, int par) const {
        const int row0 = u.pm * BM + wr * 64 + fr, col0 = u.pn * BM + wc * 32 + 8 * fq;
        const f32x4 g0 = *(const f32x4*)(gain + wc * 32 + 8 * fq), g1 = *(const f32x4*)(gain + wc * 32 + 8 * fq + 4);
#pragma unroll
        for (int ai = 0; ai < 2; ++ai)
#pragma unroll
            for (int m = 0; m < 4; ++m) { float ss = 0.f;
#pragma unroll
                for (int n = 0; n < 2; ++n)
#pragma unroll
                    for (int e = 0; e < 4; ++e) ss += acc[ai][0][m][n][e] * acc[ai][0][m][n][e];
                { auto r = __builtin_amdgcn_permlane16_swap(__float_as_uint(ss), __float_as_uint(ss), false, false); ss = __uint_as_float(r[0]) + __uint_as_float(r[1]); }
                { auto r = __builtin_amdgcn_permlane32_swap(__float_as_uint(ss), __float_as_uint(ss), false, false); ss = __uint_as_float(r[0]) + __uint_as_float(r[1]); }
                if (fq == 0) xs[(ai * HALF + wr * 64 + m * 16 + fr) * 4 + wc] = ss; }
        asm volatile("s_waitcnt lgkmcnt(0)" ::: "memory"); __builtin_amdgcn_s_barrier(); asm volatile("" ::: "memory");
#pragma unroll
        for (int ai = 0; ai < 2; ++ai)
#pragma unroll
            for (int m = 0; m < 4; ++m) { const f32x4 t = *(const LAS f32x4*)(xs + (ai * HALF + wr * 64 + m * 16 + fr) * 4);
                const float r = 1.0f / sqrtf(((t.x + t.y) + (t.z + t.w)) * (1.f / 128.f) + 1e-6f);
                bf16_t* rowp = O + (size_t)(row0 + ai * HALF + m * 16) * ldc + col0;
                { float v[8]; const f32x4 a0 = acc[ai][0][m][0], a1 = acc[ai][0][m][1];
                  v[0] = a0.x * r * g0.x; v[1] = a0.y * r * g0.y; v[2] = a0.z * r * g0.z; v[3] = a0.w * r * g0.w; v[4] = a1.x * r * g1.x; v[5] = a1.y * r * g1.y; v[6] = a1.z * r * g1.z; v[7] = a1.w * r * g1.w;
                  *(bf16x8*)rowp = pack8(v); }
                { float v[8]; const f32x4 a0 = acc[ai][1][m][0], a1 = acc[ai][1][m][1];
                  v[0] = a0.x; v[1] = a0.y; v[2] = a0.z; v[3] = a0.w; v[4] = a1.x; v[5] = a1.y; v[6] = a1.z; v[7] = a1.w;
                  *(bf16x8*)(rowp + HALF) = pack8(v); } }
    }
};

template <class Epi, class Sched, bool ALIGN_EPI = true>
__device__ __forceinline__ void gemm_phase(LAS unsigned char* lds, const Gemm g, const Sched& S, const Epi& E, int tid_in, const Gate gate = Gate{nullptr, 0u, nullptr, nullptr, -1, 32}) {
    int tid_ = tid_in; asm volatile("" : "+v"(tid_));
    const int tid = tid_, wid = __builtin_amdgcn_readfirstlane(tid >> 6), lane = tid & 63, wr = wid >> 2, wc = wid & 3, fr = lane & 15, fq = lane >> 4;
    unsigned voffA[2], voffB[2];
#pragma unroll
    for (int i = 0; i < 2; ++i) { int R, C; stage_rc(tid * 16 + i * 8192, R, C); const int Rb = Epi::PERM ? ((R & ~31) + perm32(R & 31)) : R;
        voffA[i] = (unsigned)(R * g.lda + C) * 2u; voffB[i] = (unsigned)(Rb * g.ldb + C) * 2u; }
    const size_t kstep = (size_t)(BK * 2);
    const size_t hsA = (size_t)HALF * g.lda * 2, hsB = (size_t)HALF * g.ldb * 2;
    const size_t tsA = 2 * hsA, tsB = 2 * hsB;
    const unsigned ldsw = (unsigned)wid * 1024u;
    const int aoff = lds_byte(wr * 64 + fr, fq * 8), boff = lds_byte(wc * 32 + fr, fq * 8);
#define PG8_SA(b, h) (((b) * 2 + (h)) * HTB)
#define PG8_SB(b, h) ((4 + (b) * 2 + (h)) * HTB)
#define PG8_STAGE(bufoff, gbase, voff) do { _Pragma("unroll") for (int _i = 0; _i < 2; ++_i) \
        __builtin_amdgcn_global_load_lds((const unsigned*)((const char*)(gbase) + (voff)[_i]), (LAS unsigned*)(lds + (bufoff) + ldsw + _i * 8192), 16, 0, 0); } while (0)
#define PG8_LDA(dst, b, h) do { _Pragma("unroll") for (int m = 0; m < 4; ++m) _Pragma("unroll") for (int k = 0; k < 2; ++k) dst[m][k] = *(const LAS bf16x8*)(lds + PG8_SA(b, h) + aoff + m * 2048 + k * 1024); } while (0)
#define PG8_LDB(dst, b, h) do { _Pragma("unroll") for (int n = 0; n < 2; ++n) _Pragma("unroll") for (int k = 0; k < 2; ++k) dst[n][k] = *(const LAS bf16x8*)(lds + PG8_SB(b, h) + boff + n * 2048 + k * 1024); } while (0)
#define PG8_MMA(ai, bj, At, Bt) do { __builtin_amdgcn_s_setprio(1); _Pragma("unroll") for (int m = 0; m < 4; ++m) _Pragma("unroll") for (int n = 0; n < 2; ++n) _Pragma("unroll") for (int k = 0; k < 2; ++k) \
        acc[ai][bj][m][n] = __builtin_amdgcn_mfma_f32_16x16x32_bf16(Bt[n][k], At[m][k], acc[ai][bj][m][n], 0, 0, 0); __builtin_amdgcn_s_setprio(0); } while (0)
#define PG8_WAIT_V(n) asm volatile("s_waitcnt vmcnt(" #n ")" ::: "memory")
#define PG8_WAIT_L(n) asm volatile("s_waitcnt lgkmcnt(" #n ")" ::: "memory")
#define PG8_BAR __builtin_amdgcn_s_barrier()
#define PG8_SCHED __builtin_amdgcn_sched_barrier(0)
    Unit cur, nxt; int ui = 0;
    if (!S.next(0, cur)) return;
    bool open = (gate.evt == nullptr);
    if (!open && cur.pm >= gate.pm0) { if (tid == 0) evt_wait_one(gate); __syncthreads(); open = true; }
    if (open) E.prefetch(cur, wid, lane, 0);
    f32x4 acc[2][2][4][2];
#pragma unroll
    for (int a = 0; a < 2; ++a)
#pragma unroll
        for (int b = 0; b < 2; ++b)
#pragma unroll
            for (int m = 0; m < 4; ++m)
#pragma unroll
                for (int n = 0; n < 2; ++n) acc[a][b][m][n] = (f32x4){0.f, 0.f, 0.f, 0.f};
    bf16x8 At[4][2], B0[2][2], B1[2][2];
    const char* cA = (const char*)g.A + (size_t)cur.pm * tsA + (size_t)cur.pn * g.apn + (size_t)cur.kt0 * kstep; const char* cB = (const char*)g.Bt + (size_t)cur.pn * tsB + (size_t)cur.kt0 * kstep;
    S.a_ready(cur);
    PG8_STAGE(PG8_SB(0, 0), cB, voffB); PG8_STAGE(PG8_SB(0, 1), cB + hsB, voffB); PG8_STAGE(PG8_SA(0, 0), cA, voffA); PG8_STAGE(PG8_SA(0, 1), cA + hsA, voffA);
    if (wr == 1) PG8_BAR;
    PG8_WAIT_V(2); PG8_BAR;
    PG8_STAGE(PG8_SB(1, 0), cB + kstep, voffB); PG8_STAGE(PG8_SA(1, 0), cA + kstep, voffA); PG8_STAGE(PG8_SB(1, 1), cB + hsB + kstep, voffB);
    PG8_WAIT_V(6); PG8_BAR;
    for (;;) {
        const bool has_next = S.next(ui + 1, nxt);
        const char* nA = has_next ? (const char*)g.A + (size_t)nxt.pm * tsA + (size_t)nxt.pn * g.apn + (size_t)nxt.kt0 * kstep : cA; const char* nB = has_next ? (const char*)g.Bt + (size_t)nxt.pn * tsB + (size_t)nxt.kt0 * kstep : cB;
        const int nt = cur.nkt;
        for (int t = 0; t < nt; t += 2) {
            const bool last = (t == nt - 2);
            const char* a1 = cA + (size_t)(t + 1) * kstep;
            const char* a2 = last ? nA : cA + (size_t)(t + 2) * kstep; const char* b2 = last ? nB : cB + (size_t)(t + 2) * kstep;
            const char* a3 = a2 + kstep; const char* b3 = b2 + kstep;
            if (last && has_next) S.a_ready(nxt);
            const bool gate_now = !open && (gate.tg < 0 ? last : t == gate.tg);
            if (gate_now && tid == 0) evt_wait_one(gate);
            PG8_LDB(B0, 0, 0); PG8_LDB(B1, 0, 1); PG8_SCHED; PG8_LDA(At, 0, 0); PG8_STAGE(PG8_SA(1, 1), a1 + hsA, voffA);
            PG8_WAIT_V(8); PG8_WAIT_L(0); PG8_BAR; PG8_MMA(0, 0, At, B0); PG8_MMA(0, 1, At, B1); PG8_BAR; PG8_SCHED;
            if (gate_now) { E.prefetch(cur, wid, lane, ui & 1); open = true; }
            PG8_LDA(At, 0, 1); PG8_STAGE(PG8_SB(0, 0), b2, voffB); PG8_STAGE(PG8_SB(0, 1), b2 + hsB, voffB); PG8_STAGE(PG8_SA(0, 0), a2, voffA);
            PG8_WAIT_V(8); PG8_WAIT_L(0); PG8_BAR; PG8_MMA(1, 0, At, B0); PG8_MMA(1, 1, At, B1); PG8_BAR; PG8_SCHED;
            PG8_LDB(B0, 1, 0); PG8_LDB(B1, 1, 1); PG8_SCHED; PG8_LDA(At, 1, 0); PG8_STAGE(PG8_SA(0, 1), a2 + hsA, voffA);
            PG8_WAIT_V(8); PG8_WAIT_L(0); PG8_BAR; PG8_MMA(0, 0, At, B0); PG8_MMA(0, 1, At, B1); PG8_BAR; PG8_SCHED;
            PG8_LDA(At, 1, 1); PG8_STAGE(PG8_SB(1, 0), b3, voffB); PG8_STAGE(PG8_SB(1, 1), b3 + hsB, voffB); PG8_STAGE(PG8_SA(1, 0), a3, voffA);
            PG8_WAIT_V(8); PG8_WAIT_L(0); PG8_BAR; PG8_MMA(1, 0, At, B0); PG8_MMA(1, 1, At, B1); PG8_BAR; PG8_SCHED;
        }
        if constexpr (ALIGN_EPI) { if (wr == 0) PG8_BAR; }
        E(acc, cur, wr, wc, fr, fq, ui & 1); S.done(cur);
        if (!has_next) break;
#pragma unroll
        for (int a = 0; a < 2; ++a)
#pragma unroll
            for (int b = 0; b < 2; ++b)
#pragma unroll
                for (int m = 0; m < 4; ++m)
#pragma unroll
                    for (int n = 0; n < 2; ++n) acc[a][b][m][n] = (f32x4){0.f, 0.f, 0.f, 0.f};
        cur = nxt; cA = nA; cB = nB; ++ui;
        E.prefetch(cur, wid, lane, ui & 1);
        if constexpr (ALIGN_EPI) { if (wr == 1) PG8_BAR; }
    }
    PG8_WAIT_V(0);
    if constexpr (!ALIGN_EPI) { if (wr == 0) PG8_BAR; }
    PG8_BAR;
#undef PG8_SA
#undef PG8_SB
#undef PG8_STAGE
#undef PG8_LDA
#undef PG8_LDB
#undef PG8_MMA
#undef PG8_WAIT_V
#undef PG8_WAIT_L
#undef PG8_BAR
#undef PG8_SCHED
}
}

#define XB_TMO      128
#define XB_XCNT(j)  (256  + 64 * (j))
#define XB_XSUB(j)  (1280 + 64 * (j))
#define XB_XGEN(j)  (2304 + 64 * (j))
#define XB_TOP      3328
#define XB_TOPGEN   3392
#define XCD_BAR_WORDS 3456
#define XB_SPIN_CAP (1u << 18)
__device__ __forceinline__ unsigned xb_ld(unsigned* p)              { return __hip_atomic_load(p, __ATOMIC_RELAXED, __HIP_MEMORY_SCOPE_AGENT); }
__device__ __forceinline__ unsigned xb_add(unsigned* p, unsigned v) { return __hip_atomic_fetch_add(p, v, __ATOMIC_RELAXED, __HIP_MEMORY_SCOPE_AGENT); }
__device__ __forceinline__ unsigned xb_xcc_id() { return (unsigned)__builtin_amdgcn_s_getreg((3 << 11) | 20) & 0xFu; }
#define XB_SPIN(cond, bar) do { unsigned _sp = 0; while (cond) { __builtin_amdgcn_s_sleep(1); \
    if ((++_sp & 255u) == 0u) { if (xb_ld(&(bar)[XB_TMO])) break; if (_sp > XB_SPIN_CAP) { atomicAdd(&(bar)[XB_TMO], 1u); break; } } } } while (0)
struct XcdBarrier { unsigned* bar; unsigned x; volatile LAS unsigned* st; };
__device__ __forceinline__ XcdBarrier xcd_barrier_post(unsigned* bar, volatile LAS unsigned* st) {
    XcdBarrier b; b.bar = bar; b.x = xb_xcc_id(); b.st = st;
    if (threadIdx.x == 0) (void)xb_add(&bar[XB_XCNT(b.x)], 1u);
    return b;
}
__device__ __forceinline__ void xcd_barrier_complete(unsigned* bar, unsigned x, unsigned& nloc, unsigned& nx) {
    const unsigned G = gridDim.x * gridDim.y * gridDim.z;
    unsigned sum, cnt, mine, sp = 0u;
    for (;;) {
        sum = 0u; cnt = 0u; mine = 0u;
#pragma unroll
        for (unsigned j = 0; j < 16; ++j) { const unsigned c = xb_ld(&bar[XB_XCNT(j)]); sum += c; cnt += (c > 0u) ? 1u : 0u; mine = (j == x) ? c : mine; }
        if (sum == G) break;
        __builtin_amdgcn_s_sleep(1);
        if ((++sp & 255u) == 0u) { if (xb_ld(&bar[XB_TMO])) break; if (sp > XB_SPIN_CAP) { atomicAdd(&bar[XB_TMO], 1u); break; } }
    }
    nloc = mine > 0u ? mine : 1u; nx = cnt > 0u ? cnt : 1u;
}
__device__ __forceinline__ void xcd_barrier(const XcdBarrier& b) {
    asm volatile("s_waitcnt vmcnt(0)" ::: "memory");
    __syncthreads();
    if (threadIdx.x == 0) {
        unsigned* bar = b.bar;
        __builtin_amdgcn_s_waitcnt(0);
        unsigned nloc = b.st[0], nx = b.st[1];
        if (nloc == 0u) { xcd_barrier_complete(bar, b.x, nloc, nx); b.st[0] = nloc; b.st[1] = nx; }
        const unsigned old = xb_add(&bar[XB_XSUB(b.x)], 1u);
        const unsigned gen = old / nloc;
        if (old + 1u == (gen + 1u) * nloc) {
            __builtin_amdgcn_fence(__ATOMIC_RELEASE, "agent");
            asm volatile("s_waitcnt vmcnt(0)" ::: "memory");
            const unsigned og = xb_add(&bar[XB_TOP], 1u);
            const unsigned tg = og / nx;
            if (og + 1u == (tg + 1u) * nx) xb_add(&bar[XB_TOPGEN], 1u);
            else XB_SPIN(xb_ld(&bar[XB_TOPGEN]) == tg, bar);
            __builtin_amdgcn_fence(__ATOMIC_ACQUIRE, "agent");
            xb_add(&bar[XB_XGEN(b.x)], 1u);
            asm volatile("s_waitcnt vmcnt(0)" ::: "memory");
        } else {
            XB_SPIN(xb_ld(&bar[XB_XGEN(b.x)]) == gen, bar);
            __builtin_amdgcn_fence(__ATOMIC_ACQUIRE, "agent");
            asm volatile("s_waitcnt vmcnt(0)" ::: "memory");
        }
    }
    __syncthreads();
}

struct Args { const float* in[31]; float* out; unsigned char* ws; int lo, hi; int plan[48]; };
#define INP(i) ((const float*)(const GAS float*)a.in[({ int _i = (i); asm volatile("" : "+s"(_i)); _i; })])
struct Frame { LAS unsigned char* lds; int tid, lane, wave, vcu, G, gw, NGW; };
__device__ __forceinline__ Frame make_frame(LAS unsigned char* lds, int wave0) {
    Frame F; int ln; asm volatile("v_mbcnt_lo_u32_b32 %0, -1, 0\n\tv_mbcnt_hi_u32_b32 %0, -1, %0" : "=v"(ln)); int bx = blockIdx.x;        asm volatile("" : "+s"(bx));
    const int t = wave0 * 64 + ln;
    F.lds = lds; F.tid = t; F.lane = ln; F.wave = wave0;
    F.G = gridDim.x; F.vcu = (F.G % 8 == 0) ? (bx % 8) * (F.G / 8) + bx / 8 : bx;
    F.gw = F.vcu * 8 + F.wave; F.NGW = F.G * 8; return F;
}

__device__ __forceinline__ void tr_load(f32x4 (&v)[16], const float* W, int N, int item, int lane) {
    const int nblk = N / 64, kb = item / nblk, nb = item % nblk, k0 = 64 * kb, n0 = 64 * nb;
    const int lr = lane >> 4, lc = (lane & 15) * 4;
#pragma unroll
    for (int i = 0; i < 16; ++i) v[i] = __builtin_nontemporal_load((const f32x4*)(W + (size_t)(k0 + 4 * i + lr) * N + n0 + lc));
}
__device__ __forceinline__ void tr_to_lds(const f32x4 (&v)[16], LAS float* scr, int lane) {
    const int lr = lane >> 4, lc = (lane & 15) * 4;
#pragma unroll
    for (int i = 0; i < 16; ++i) { LAS float* d = scr + (4 * i + lr) * 65 + lc; d[0] = v[i].x; d[1] = v[i].y; d[2] = v[i].z; d[3] = v[i].w; }
}
template <class RowMap>
__device__ __forceinline__ void tr_emit(int K, int N, bf16_t* WT, const RowMap& rm, LAS float* scr, int item, int lane, const float* gk) {
    const int nblk = N / 64, kb = item / nblk, nb = item % nblk, k0 = 64 * kb, n0 = 64 * nb;
    LDS_WAIT(); asm volatile("" ::: "memory");
    const int c = lane & 7;
    f32x4 ga = {1.f, 1.f, 1.f, 1.f}, gb = {1.f, 1.f, 1.f, 1.f};
    if (gk) { ga = *(const f32x4*)(gk + k0 + 8 * c); gb = *(const f32x4*)(gk + k0 + 8 * c + 4); }
#pragma unroll
    for (int j = 0; j < 8; ++j) { const int n = (lane >> 3) + 8 * j; const LAS float* s = scr + (8 * c) * 65 + n;
        u32x4 o; o.x = cvt_pk_bf16(s[0 * 65] * ga.x, s[1 * 65] * ga.y); o.y = cvt_pk_bf16(s[2 * 65] * ga.z, s[3 * 65] * ga.w); o.z = cvt_pk_bf16(s[4 * 65] * gb.x, s[5 * 65] * gb.y); o.w = cvt_pk_bf16(s[6 * 65] * gb.z, s[7 * 65] * gb.w);
        *(u32x4*)(WT + (size_t)rm(n0 + n) * K + k0 + 8 * c) = o; }
    LDS_WAIT(); asm volatile("" ::: "memory");
}
struct RmId { int off; __device__ __forceinline__ int operator()(int n) const { return off + n; } };
struct RmAny { int mode, off; __device__ __forceinline__ int operator()(int n) const { return mode ? (n >> 7) * 256 + off + (n & 127) : off + n; } };
struct RmGU { int up; __device__ __forceinline__ int operator()(int n) const { return (n >> 7) * 256 + up * 128 + (n & 127); } };
__device__ __forceinline__ f32x4 bf4(u32x2 w) { return (f32x4){bflo(w.x), bfhi(w.x), bflo(w.y), bfhi(w.y)}; }
__device__ __forceinline__ u32x2 pk4(f32x4 v) { u32x2 w; w.x = cvt_pk_bf16(v.x, v.y); w.y = cvt_pk_bf16(v.z, v.w); return w; }
__device__ __forceinline__ void stat_pass(const Frame& F, bf16_t* xb, float* R, const bf16_t* P, float fix, const float* src0, const float* src1, const float* SSP) {
    if (!src0) {
        for (int row = F.vcu * NTHR + F.tid; row < MP; row += F.G * NTHR) { const f32x4* sp = (const f32x4*)(SSP + (size_t)row * 32); f32x4 t = sp[0];
#pragma unroll
            for (int k = 1; k < 8; ++k) t += sp[k];
            R[row] = rsq(((t.x + t.y) + (t.z + t.w)) * (1.f / DM) + EPS); }
    }
    else for (int row = F.gw; row < MP; row += 2 * F.NGW) {
        const int row2 = row + F.NGW; const bool two = row2 < MP;
        f32x4 v[2][8];
#pragma unroll
        for (int q = 0; q < 2; ++q) { const int r = q ? row2 : row; if (q == 0 || two) {
            if (src0) { const f32x4* sr = (const f32x4*)(src0 + (size_t)r * DM) + F.lane;
#pragma unroll
                for (int j = 0; j < 8; ++j) v[q][j] = sr[64 * j]; }
            else { const u32x2* sr = (const u32x2*)(xb + (size_t)r * DM) + F.lane;
#pragma unroll
                for (int j = 0; j < 8; ++j) v[q][j] = bf4(sr[64 * j]); } } }
#pragma unroll
        for (int q = 0; q < 2; ++q) { const int r = q ? row2 : row; if (q == 0 || two) {
            float s = 0.f;
            if (src0) { u32x2* xr = (u32x2*)(xb + (size_t)r * DM) + F.lane;
#pragma unroll
                for (int j = 0; j < 8; ++j) { const u32x2 w = pk4(v[q][j]); xr[64 * j] = w; v[q][j] = bf4(w); } }
#pragma unroll
            for (int j = 0; j < 8; ++j) s += (v[q][j].x * v[q][j].x + v[q][j].y * v[q][j].y) + (v[q][j].z * v[q][j].z + v[q][j].w * v[q][j].w);
            const float rr = rsq(wave_sum(s) * (1.f / DM) + EPS);
            if (F.lane == 0) R[r] = rr; } }
    }
    for (int row = MP + F.gw; row < M; row += F.NGW) {
        u32x2* xr = (u32x2*)(xb + (size_t)row * DM) + F.lane;
        f32x4 v[8]; float s = 0.f;
        if (src0) { const f32x4* sr = (const f32x4*)(src1 + (size_t)(row - MP) * DM) + F.lane;
#pragma unroll
            for (int j = 0; j < 8; ++j) v[j] = sr[64 * j]; }
        else {
#pragma unroll
            for (int j = 0; j < 8; ++j) v[j] = bf4(xr[64 * j]); }
        if (fix != 0.f) {
            const u32x2* pr = (const u32x2*)(P + (size_t)(row - MP) * DM) + F.lane;
#pragma unroll
            for (int j = 0; j < 8; ++j) { f32x4 t = {0.f, 0.f, 0.f, 0.f};
#pragma unroll
                for (int sl = 0; sl < 8; ++sl) t += bf4(pr[(size_t)sl * (1024 * 2048 / 4) + 64 * j]);
                v[j] += t * fix; }
        }
        if (src0 || fix != 0.f) {
#pragma unroll
            for (int j = 0; j < 8; ++j) { const u32x2 w = pk4(v[j]); xr[64 * j] = w; v[j] = bf4(w); }
        }
#pragma unroll
        for (int j = 0; j < 8; ++j) s += (v[j].x * v[j].x + v[j].y * v[j].y) + (v[j].z * v[j].z + v[j].w * v[j].w);
        const float rr = rsq(wave_sum(s) * (1.f / DM) + EPS);
        if (F.lane == 0) R[row] = rr;
    }
}

__device__ __forceinline__ void stat_pass2(const Frame& F, bf16_t* xb, float* R, const bf16_t* P, float fix, const float* SSP) {
    if (F.tid < 256) { const int row = 32 * F.vcu + (F.tid >> 3); const f32x4 t = *(const f32x4*)(SSP + (size_t)row * 32 + 4 * (F.tid & 7));
        float s = (t.x + t.y) + (t.z + t.w); s += dpp_f<0xB1>(s); s += dpp_f<0x4E>(s); s += dpp_f<0x141>(s);
        if ((F.tid & 7) == 0) R[row] = rsq(s * (1.f / DM) + EPS); }
    const int half = F.wave >> 2, row = MP + 4 * F.vcu + (F.wave & 3);
    u32x4* xr = (u32x4*)(xb + (size_t)row * DM + half * 1024) + F.lane;
    const u32x4* pr = (const u32x4*)(P + (size_t)(row - MP) * DM + half * 1024) + F.lane;
    u32x4 w[2], q[8][2];
#pragma unroll
    for (int j = 0; j < 2; ++j) w[j] = xr[64 * j];
#pragma unroll
    for (int sl = 0; sl < 8; ++sl)
#pragma unroll
        for (int j = 0; j < 2; ++j) q[sl][j] = pr[(size_t)sl * (1024 * 2048 / 8) + 64 * j];
    float s = 0.f;
#pragma unroll
    for (int j = 0; j < 2; ++j) {
        f32x4 t0 = {0.f, 0.f, 0.f, 0.f}, t1 = {0.f, 0.f, 0.f, 0.f};
#pragma unroll
        for (int sl = 0; sl < 8; ++sl) { t0 += bf4((u32x2){q[sl][j].x, q[sl][j].y}); t1 += bf4((u32x2){q[sl][j].z, q[sl][j].w}); }
        const f32x4 v0 = bf4((u32x2){w[j].x, w[j].y}) + t0 * fix, v1 = bf4((u32x2){w[j].z, w[j].w}) + t1 * fix;
        const u32x2 o0 = pk4(v0), o1 = pk4(v1);
        xr[64 * j] = (u32x4){o0.x, o0.y, o1.x, o1.y};
        const f32x4 r0 = bf4(o0), r1 = bf4(o1);
        s += (r0.x * r0.x + r0.y * r0.y) + (r0.z * r0.z + r0.w * r0.w) + (r1.x * r1.x + r1.y * r1.y) + (r1.z * r1.z + r1.w * r1.w);
    }
    s = wave_sum(s);
    LAS float* sc = (LAS float*)(F.lds + AUX_OFF + 6144);
    if (F.lane == 0) sc[F.wave] = s;
    __syncthreads();
    if (F.wave < 4 && F.lane == 0) R[row] = rsq((sc[F.wave] + sc[F.wave + 4]) * (1.f / DM) + EPS);
}

template <int W> __device__ __forceinline__ void pool16(const float* zc, const float* hs, bf16_t* pc, int l0, bool prm) {
    float u[W + 15];
#pragma unroll
    for (int t = 0; t < W + 15; ++t) { const int l = l0 - (W - 1) + t; u[t] = l >= 0 ? zc[(size_t)l * EVINP] : (prm ? 0.f : hs[(size_t)(15 + l) * POOLD]); }
    float sum = 0.f;
#pragma unroll
    for (int t = 0; t < W - 1; ++t) sum += u[t];
#pragma unroll
    for (int i = 0; i < 16; ++i) { const float ul = u[W - 1 + i]; sum += ul; const int l = l0 + i;
        const float cnt = prm ? (float)(l + 1 < W ? l + 1 : W) : (float)W;
        pc[(size_t)l * POOLD] = f2bf(sum / cnt - ul); sum -= u[i]; }
}

__device__ __forceinline__ int crow(int r, int hi) { return (r & 3) + 8 * (r >> 2) + 4 * hi; }
__device__ __forceinline__ int v_st(int k, int c) { const int kk = (k & ~0xC) | ((k & 4) << 1) | ((k & 8) >> 1); return ((kk >> 3) * 4 + (c >> 5)) * 512 + ((kk & 7) * 32 + (c & 31)) * 2; }
__device__ __forceinline__ int v_rd_base(int lane) { return ((lane & 3) << 3) | (((lane >> 2) & 3) << 6) | (((lane >> 4) & 1) << 5) | (((lane >> 5) & 1) << 8); }
constexpr int v_rd_off(int d0, int ks, int half) { return d0 * 512 + ks * 4096 + half * 2048; }
template <int OFF> __device__ __forceinline__ s16x4 tr_read(int vb) {
    s16x4 r; asm volatile("ds_read_b64_tr_b16 %0, %1 offset:%2" : "=&v"(r) : "v"(vb), "i"(OFF) : "memory"); return r;
}
template <int D0> __device__ __forceinline__ void pv_one32(f32x16& od, int vb, bf16x8 pa0, bf16x8 pa1) {
    const s16x4 l0 = tr_read<v_rd_off(D0, 0, 0)>(vb), h0 = tr_read<v_rd_off(D0, 0, 1)>(vb), l1 = tr_read<v_rd_off(D0, 1, 0)>(vb), h1 = tr_read<v_rd_off(D0, 1, 1)>(vb);
    asm volatile("s_waitcnt lgkmcnt(0)" ::: "memory"); SBAR();
#define PK(L, H) (bf16x8){L[0], L[1], L[2], L[3], H[0], H[1], H[2], H[3]}
    od = __builtin_amdgcn_mfma_f32_32x32x16_bf16(pa0, PK(l0, h0), od, 0, 0, 0);
    od = __builtin_amdgcn_mfma_f32_32x32x16_bf16(pa1, PK(l1, h1), od, 0, 0, 0);
#undef PK
}
__device__ __forceinline__ void pv32(f32x16* o, int vb, bf16x8 pa0, bf16x8 pa1) {
    const s16x4 a0 = tr_read<v_rd_off(0, 0, 0)>(vb), a1 = tr_read<v_rd_off(0, 0, 1)>(vb), a2 = tr_read<v_rd_off(0, 1, 0)>(vb), a3 = tr_read<v_rd_off(0, 1, 1)>(vb);
    const s16x4 b0 = tr_read<v_rd_off(1, 0, 0)>(vb), b1 = tr_read<v_rd_off(1, 0, 1)>(vb), b2 = tr_read<v_rd_off(1, 1, 0)>(vb), b3 = tr_read<v_rd_off(1, 1, 1)>(vb);
    const s16x4 c0 = tr_read<v_rd_off(2, 0, 0)>(vb), c1 = tr_read<v_rd_off(2, 0, 1)>(vb), c2 = tr_read<v_rd_off(2, 1, 0)>(vb), c3 = tr_read<v_rd_off(2, 1, 1)>(vb);
    const s16x4 d0 = tr_read<v_rd_off(3, 0, 0)>(vb), d1 = tr_read<v_rd_off(3, 0, 1)>(vb), d2 = tr_read<v_rd_off(3, 1, 0)>(vb), d3 = tr_read<v_rd_off(3, 1, 1)>(vb);
    asm volatile("s_waitcnt lgkmcnt(0)" ::: "memory"); SBAR();
#define PK(L, H) (bf16x8){L[0], L[1], L[2], L[3], H[0], H[1], H[2], H[3]}
    o[0] = __builtin_amdgcn_mfma_f32_32x32x16_bf16(pa0, PK(a0, a1), o[0], 0, 0, 0); o[1] = __builtin_amdgcn_mfma_f32_32x32x16_bf16(pa0, PK(b0, b1), o[1], 0, 0, 0);
    o[2] = __builtin_amdgcn_mfma_f32_32x32x16_bf16(pa0, PK(c0, c1), o[2], 0, 0, 0); o[3] = __builtin_amdgcn_mfma_f32_32x32x16_bf16(pa0, PK(d0, d1), o[3], 0, 0, 0);
    o[0] = __builtin_amdgcn_mfma_f32_32x32x16_bf16(pa1, PK(a2, a3), o[0], 0, 0, 0); o[1] = __builtin_amdgcn_mfma_f32_32x32x16_bf16(pa1, PK(b2, b3), o[1], 0, 0, 0);
    o[2] = __builtin_amdgcn_mfma_f32_32x32x16_bf16(pa1, PK(c2, c3), o[2], 0, 0, 0); o[3] = __builtin_amdgcn_mfma_f32_32x32x16_bf16(pa1, PK(d2, d3), o[3], 0, 0, 0);
#undef PK
}
struct VFrags { s16x4 f[16]; };
__device__ __forceinline__ void pv_load(VFrags& V, int vb) {
    V.f[0] = tr_read<v_rd_off(0, 0, 0)>(vb); V.f[1] = tr_read<v_rd_off(0, 0, 1)>(vb); V.f[2] = tr_read<v_rd_off(0, 1, 0)>(vb); V.f[3] = tr_read<v_rd_off(0, 1, 1)>(vb);
    V.f[4] = tr_read<v_rd_off(1, 0, 0)>(vb); V.f[5] = tr_read<v_rd_off(1, 0, 1)>(vb); V.f[6] = tr_read<v_rd_off(1, 1, 0)>(vb); V.f[7] = tr_read<v_rd_off(1, 1, 1)>(vb);
    V.f[8] = tr_read<v_rd_off(2, 0, 0)>(vb); V.f[9] = tr_read<v_rd_off(2, 0, 1)>(vb); V.f[10] = tr_read<v_rd_off(2, 1, 0)>(vb); V.f[11] = tr_read<v_rd_off(2, 1, 1)>(vb);
    V.f[12] = tr_read<v_rd_off(3, 0, 0)>(vb); V.f[13] = tr_read<v_rd_off(3, 0, 1)>(vb); V.f[14] = tr_read<v_rd_off(3, 1, 0)>(vb); V.f[15] = tr_read<v_rd_off(3, 1, 1)>(vb);
}
__device__ __forceinline__ void pv_mma(f32x16* o, const VFrags& V, bf16x8 pa0, bf16x8 pa1) {
#define PK(L, H) (bf16x8){L[0], L[1], L[2], L[3], H[0], H[1], H[2], H[3]}
#pragma unroll
    for (int d = 0; d < 4; ++d) o[d] = __builtin_amdgcn_mfma_f32_32x32x16_bf16(pa0, PK(V.f[4 * d], V.f[4 * d + 1]), o[d], 0, 0, 0);
#pragma unroll
    for (int d = 0; d < 4; ++d) o[d] = __builtin_amdgcn_mfma_f32_32x32x16_bf16(pa1, PK(V.f[4 * d + 2], V.f[4 * d + 3]), o[d], 0, 0, 0);
#undef PK
}
#define VT_LOAD(vr, src, ld) do { _Pragma("unroll") for (int _it = 0; _it < 8; ++_it) vr[_it] = *(const bf16x8*)((src) + (size_t)(4 * _it + (lane >> 4)) * (ld) + (lane & 15) * 8); } while (0)
#define VT_WRITE(vl, vr) do { _Pragma("unroll") for (int _it = 0; _it < 8; ++_it) *(LAS bf16x8*)((vl) + v_st(4 * _it + (lane >> 4), (lane & 15) * 8)) = vr[_it]; } while (0)

__device__ __forceinline__ void load_q_frags(bf16x8 (&qr)[12], const bf16_t* Q, int row, int h, int hi, const float* tab, const float* gqn, const float* gqp) {
    const bf16_t* qp = Q + (size_t)row * 1536 + h * QKH + 8 * hi;
        bf16x8 raw[12];
#pragma unroll
        for (int d0 = 0; d0 < 12; ++d0) raw[d0] = *(const bf16x8*)(qp + 16 * d0);
        float ssn = 0.f, ssp = 0.f;
#pragma unroll
        for (int d0 = 0; d0 < 12; ++d0)
#pragma unroll
            for (int j = 0; j < 8; ++j) { const float f = bf1(raw[d0][j]); if (d0 < 8) ssn += f * f; else ssp += f * f; }
        ssn = xor32_sum(ssn); ssp = xor32_sum(ssp);
        const float rn = rsq(ssn * (1.f / NOPE) + EPS), rp = rsq(ssp * (1.f / ROPE) + EPS);
#pragma unroll
        for (int d0 = 0; d0 < 8; ++d0) { float v[8]; const float* gp = gqn + 16 * d0 + 8 * hi;
#pragma unroll
            for (int j = 0; j < 8; ++j) v[j] = bf1(raw[d0][j]) * rn * gp[j];
            qr[d0] = pack8(v); }
#pragma unroll
        for (int d0 = 8; d0 < 10; ++d0) { float v1[8], v2[8]; const int i0 = 16 * (d0 - 8) + 8 * hi; const float* tp = tab + (size_t)row * 64 + i0;
#pragma unroll
            for (int j = 0; j < 8; ++j) { const float x1 = bf1(raw[d0][j]) * rp * gqp[i0 + j], x2 = bf1(raw[d0 + 2][j]) * rp * gqp[i0 + 32 + j]; const float c = tp[j], s = tp[32 + j];
                v1[j] = x1 * c - x2 * s; v2[j] = x1 * s + x2 * c; }
            qr[d0] = pack8(v1); qr[d0 + 2] = pack8(v2); }
}

struct AttnUnit { int qrow0, h, ntiles; const bf16_t* kv; const bf16_t* kpe; };
__device__ __forceinline__ void attn_unit(const Frame& F, const AttnUnit& U, const bf16_t* Q, const float* tab, const float* gqn, const float* gqp, bf16_t* mix) {
    int lane_; asm volatile("v_mbcnt_lo_u32_b32 %0, -1, 0\n\tv_mbcnt_hi_u32_b32 %0, -1, %0" : "=v"(lane_));
    const int lane = lane_, wid = F.wave, r32 = lane & 31, hi = lane >> 5;
    LAS unsigned char* lds = F.lds;
    constexpr int QF_OFF = 102400, KVT = 12800;
    {
        bf16x8 qr[12];
        load_q_frags(qr, Q, U.qrow0 + r32, U.h, hi, tab, gqn, gqp);
        if (wid == 0) {
#pragma unroll
            for (int d0 = 0; d0 < 12; ++d0) *(LAS bf16x8*)(lds + QF_OFF + d0 * 1024 + lane * 16) = qr[d0]; }
    }
    __syncthreads();
    f32x16 o[4];
#pragma unroll
    for (int d = 0; d < 4; ++d)
#pragma unroll
        for (int r = 0; r < 16; ++r) o[d][r] = 0.f;
    float m_reg = -1e30f, l_reg = 0.f;
    LAS unsigned char* vl = lds + wid * KVT;
    LAS float* aux = (LAS float*)(lds + AUX_OFF);
    LAS float* al_l = aux + 768 + wid * 32;
    const int vb = (int)(uintptr_t)vl + v_rd_base(lane);
    const bf16_t* kvh = U.kv + U.h * 256;
    bf16x8 kf[12], vr[8];
#define KLOAD(t_) do { const bf16_t* kp_ = kvh + (size_t)(32 * (t_) + (lane >> 4)) * 2048 + 8 * (lane & 15); const bf16_t* pp_ = U.kpe + (size_t)(32 * (t_) + (lane >> 3)) * 64 + 8 * (lane & 7); \
        _Pragma("unroll") for (int i_ = 0; i_ < 8; ++i_) kf[i_] = *(const bf16x8*)(kp_ + (size_t)(4 * i_) * 2048);        \
        _Pragma("unroll") for (int i_ = 0; i_ < 4; ++i_) kf[8 + i_] = *(const bf16x8*)(pp_ + (size_t)(8 * i_) * 64); } while (0)
#define KWRITE() do { _Pragma("unroll") for (int i_ = 0; i_ < 8; ++i_) *(LAS bf16x8*)(vl + (4 * i_ + (lane >> 4)) * 400 + 16 * (lane & 15)) = kf[i_]; \
        _Pragma("unroll") for (int i_ = 0; i_ < 4; ++i_) *(LAS bf16x8*)(vl + (8 * i_ + (lane >> 3)) * 400 + 256 + 16 * (lane & 7)) = kf[8 + i_]; } while (0)
    int t = wid;
    if (t < U.ntiles) { KLOAD(t); VT_LOAD(vr, kvh + (size_t)(32 * t) * 2048 + 128, 2048); }
    for (; t < U.ntiles; t += 8) {
        const int tn = t + 8;
        KWRITE();
        bf16x8 kq[12];
#pragma unroll
        for (int d0 = 0; d0 < 12; ++d0) kq[d0] = *(const LAS bf16x8*)(vl + r32 * 400 + 32 * d0 + 16 * hi);
        f32x16 p;
#pragma unroll
        for (int r = 0; r < 16; ++r) p[r] = 0.f;
#pragma unroll
        for (int d0 = 0; d0 < 12; ++d0) { const bf16x8 qf = *(const LAS bf16x8*)(lds + QF_OFF + d0 * 1024 + lane * 16); p = __builtin_amdgcn_mfma_f32_32x32x16_bf16(kq[d0], qf, p, 0, 0, 0); }
        if (tn < U.ntiles) KLOAD(tn);
        VT_WRITE(vl, vr);
        if (tn < U.ntiles) VT_LOAD(vr, kvh + (size_t)(32 * tn) * 2048 + 128, 2048);
        float pmax = p[0];
#pragma unroll
        for (int r = 1; r < 16; ++r) pmax = fmaxf(pmax, p[r]);
        pmax = xor32_max(pmax);
        const float mn = fmaxf(m_reg, pmax);
        const float alpha = __builtin_amdgcn_exp2f((m_reg - mn) * ATTN_C);
        m_reg = mn;
        const float mnC = mn * ATTN_C;
        float ps = 0.f;
#pragma unroll
        for (int r = 0; r < 16; ++r) { p[r] = __builtin_amdgcn_exp2f(fmaf(p[r], ATTN_C, -mnC)); ps += p[r]; }
        ps = xor32_sum(ps);
        l_reg = l_reg * alpha + ps;
        if (__any(alpha < 1.f)) {
            if (hi == 0) al_l[r32] = alpha;
            LDS_WAIT();
#pragma unroll
            for (int r = 0; r < 16; ++r) { const float a = al_l[crow(r, hi)];
#pragma unroll
                for (int d = 0; d < 4; ++d) o[d][r] *= a; }
        }
        bf16x8 pa0, pa1;
#define PK4(P, BASE, OUT) do { unsigned a0 = cvt_pk_bf16(P[BASE + 0], P[BASE + 1]), a1 = cvt_pk_bf16(P[BASE + 2], P[BASE + 3]);   \
    unsigned b0 = cvt_pk_bf16(P[BASE + 4], P[BASE + 5]), b1 = cvt_pk_bf16(P[BASE + 6], P[BASE + 7]);                              \
    auto r0 = __builtin_amdgcn_permlane32_swap(a0, b0, false, false); auto r1 = __builtin_amdgcn_permlane32_swap(a1, b1, false, false); \
    u32x4 w = {r0[0], r1[0], r0[1], r1[1]}; OUT = __builtin_bit_cast(bf16x8, w); } while (0)
        PK4(p, 0, pa0); PK4(p, 8, pa1);
#undef PK4
        pv32(o, vb, pa0, pa1);
    }
#undef KLOAD
#undef KWRITE
    if (hi == 0) { aux[wid * 32 + r32] = m_reg; aux[256 + wid * 32 + r32] = l_reg; }
    __syncthreads();
    float Mx = -1e30f;
#pragma unroll
    for (int w = 0; w < 8; ++w) Mx = fmaxf(Mx, aux[w * 32 + r32]);
    float L = 0.f;
#pragma unroll
    for (int w = 0; w < 8; ++w) L += aux[256 + w * 32 + r32] * __builtin_amdgcn_exp2f((aux[w * 32 + r32] - Mx) * ATTN_C);
    const float sc = __builtin_amdgcn_exp2f((m_reg - Mx) * ATTN_C) / L;
    if (hi == 0) aux[512 + wid * 32 + r32] = sc;
    LDS_WAIT();
    LAS float* ob = (LAS float*)lds + wid * 4096;
#pragma unroll
    for (int r = 0; r < 16; ++r) { const int row = crow(r, hi); const float a = aux[512 + wid * 32 + row];
#pragma unroll
        for (int d = 0; d < 4; ++d) ob[row * 128 + 32 * d + r32] = o[d][r] * a; }
    __syncthreads();
    {
        const int tid = wid * 64 + lane, row = tid >> 4, c8 = (tid & 15) * 8;
        f32x4 s0 = {0.f, 0.f, 0.f, 0.f}, s1 = {0.f, 0.f, 0.f, 0.f};
#pragma unroll
        for (int w = 0; w < 8; ++w) { const LAS f32x4* pw = (const LAS f32x4*)((LAS float*)lds + w * 4096 + row * 128 + c8); s0 += pw[0]; s1 += pw[1]; }
        float v[8] = {s0.x, s0.y, s0.z, s0.w, s1.x, s1.y, s1.z, s1.w};
        *(bf16x8*)(mix + (size_t)(U.qrow0 + row) * 2048 + 1024 + U.h * 128 + c8) = pack8(v);
    }
    __syncthreads();
}

constexpr int AT_VPM = 12;
constexpr int AT_KP = 400, AT_K = 0, AT_V = 64 * AT_KP, AT_BUF = AT_V + 16384;
__device__ __forceinline__ void attn_unit128(const Frame& F, int h, int qb4, const bf16_t* Q, const bf16_t* kv, const bf16_t* kpe, const float* tab, const float* gqn, const float* gqp, bf16_t* mix) {
    int lane_; asm volatile("v_mbcnt_lo_u32_b32 %0, -1, 0\n\tv_mbcnt_hi_u32_b32 %0, -1, %0" : "=v"(lane_));
    const int lane = lane_, wid = F.wave, r32 = lane & 31, hi = lane >> 5, qs = wid & 3, kg = wid >> 2, tid = wid * 64 + lane;
    LAS unsigned char* lds = F.lds;
    const int q0 = 128 * qb4, nst = 2 * qb4 + 2, mylast = 2 * qb4 + (qs >> 1);
    bf16x8 qr[12];
    load_q_frags(qr, Q, q0 + 32 * qs + r32, h, hi, tab, gqn, gqp);
    f32x16 o[4];
#pragma unroll
    for (int d = 0; d < 4; ++d)
#pragma unroll
        for (int r = 0; r < 16; ++r) o[d][r] = 0.f;
    float m_reg = -1e30f, l_reg = 0.f;
    LAS float* aux = (LAS float*)(lds + AUX_OFF);
    LAS float* al_l = aux + 768 + wid * 32;
    const bf16_t* kvh = kv + h * 256;
    const int vrow = tid >> 4, vcc = tid & 15;
    const int prow = tid >> 3, pcc = tid & 7;
    const unsigned vdst = (unsigned)(AT_V + v_st(vrow, 8 * vcc)), kdst = (unsigned)(AT_K + vrow * AT_KP + 16 * vcc), pdst = (unsigned)(AT_K + prow * AT_KP + 256 + 16 * pcc);
    bf16x8 sr[5];
#define AT_LOAD(j_) do { const bf16_t* b_ = kvh + (size_t)(64 * (j_)) * 2048; \
        sr[0] = *(const bf16x8*)(b_ + (size_t)vrow * 2048 + 128 + 8 * vcc); sr[1] = *(const bf16x8*)(b_ + (size_t)(vrow + 32) * 2048 + 128 + 8 * vcc); \
        sr[2] = *(const bf16x8*)(b_ + (size_t)vrow * 2048 + 8 * vcc); sr[3] = *(const bf16x8*)(b_ + (size_t)(vrow + 32) * 2048 + 8 * vcc); \
        sr[4] = *(const bf16x8*)(kpe + (size_t)(64 * (j_) + prow) * 64 + 8 * pcc); } while (0)
#define AT_WRITE(b_) do { LAS unsigned char* s_ = lds + (b_) * AT_BUF; \
        *(LAS bf16x8*)(s_ + vdst) = sr[0]; *(LAS bf16x8*)(s_ + vdst + 8192) = sr[1]; \
        *(LAS bf16x8*)(s_ + kdst) = sr[2]; *(LAS bf16x8*)(s_ + kdst + 32 * AT_KP) = sr[3]; *(LAS bf16x8*)(s_ + pdst) = sr[4]; } while (0)
    AT_LOAD(0); AT_WRITE(0);
    __syncthreads();
    const int kro = AT_K + (32 * kg + r32) * AT_KP + 16 * hi;
    const int vbb = (int)(uintptr_t)lds + AT_V + kg * 8192 + v_rd_base(lane);
    VFrags VF;
#pragma unroll
    for (int i = 0; i < 16; ++i) VF.f[i] = (s16x4){0, 0, 0, 0};
    bf16x8 pa0 = {0, 0, 0, 0, 0, 0, 0, 0}, pa1 = {0, 0, 0, 0, 0, 0, 0, 0};
    for (int j = 0; j < nst; ++j) {
        const int b = j & 1;
        if (j + 1 < nst) AT_LOAD(j + 1);
        if (j <= mylast) {
            const LAS unsigned char* ks = lds + b * AT_BUF + kro;
            f32x16 p;
#pragma unroll
            for (int r = 0; r < 16; ++r) p[r] = 0.f;
            { bf16x8 ka[4], kb[4];
#pragma unroll
              for (int d0 = 0; d0 < 4; ++d0) ka[d0] = *(const LAS bf16x8*)(ks + 32 * d0);
#pragma unroll
              for (int d0 = 0; d0 < 4; ++d0) kb[d0] = *(const LAS bf16x8*)(ks + 32 * (4 + d0));
              SBAR();
#pragma unroll
              for (int d0 = 0; d0 < 4; ++d0) p = __builtin_amdgcn_mfma_f32_32x32x16_bf16(ka[d0], qr[d0], p, 0, 0, 0);
              SBAR();
#pragma unroll
              for (int d0 = 0; d0 < 4; ++d0) ka[d0] = *(const LAS bf16x8*)(ks + 32 * (8 + d0));
              SBAR();
#pragma unroll
              for (int d0 = 0; d0 < 4; ++d0) p = __builtin_amdgcn_mfma_f32_32x32x16_bf16(kb[d0], qr[4 + d0], p, 0, 0, 0);
              SBAR();
#pragma unroll
              for (int d0 = 0; d0 < 4; ++d0) p = __builtin_amdgcn_mfma_f32_32x32x16_bf16(ka[d0], qr[8 + d0], p, 0, 0, 0); }
            asm volatile("s_waitcnt lgkmcnt(0)" ::: "memory"); SBAR();
            pv_mma(o, VF, pa0, pa1);
            float pmax = p[0];
#pragma unroll
            for (int r = 1; r < 16; ++r) pmax = fmaxf(pmax, p[r]);
            pmax = xor32_max(pmax);
            const float mn = fmaxf(m_reg, pmax);
            const float alpha = __builtin_amdgcn_exp2f((m_reg - mn) * ATTN_C);
            m_reg = mn;
            const float mnC = mn * ATTN_C;
            float ps = 0.f;
#pragma unroll
            for (int r = 0; r < 16; ++r) { p[r] = __builtin_amdgcn_exp2f(fmaf(p[r], ATTN_C, -mnC)); ps += p[r]; }
            ps = xor32_sum(ps);
            l_reg = l_reg * alpha + ps;
            bf16x8 na0, na1;
#define PK4(P, BASE, OUT) do { unsigned a0 = cvt_pk_bf16(P[BASE + 0], P[BASE + 1]), a1 = cvt_pk_bf16(P[BASE + 2], P[BASE + 3]);   \
    unsigned b0 = cvt_pk_bf16(P[BASE + 4], P[BASE + 5]), b1 = cvt_pk_bf16(P[BASE + 6], P[BASE + 7]);                              \
    auto r0 = __builtin_amdgcn_permlane32_swap(a0, b0, false, false); auto r1 = __builtin_amdgcn_permlane32_swap(a1, b1, false, false); \
    u32x4 w = {r0[0], r1[0], r0[1], r1[1]}; OUT = __builtin_bit_cast(bf16x8, w); } while (0)
            PK4(p, 0, na0); PK4(p, 8, na1);
#undef PK4
#pragma unroll
            for (int i = 0; i < 8; ++i) { __builtin_amdgcn_sched_group_barrier(0x008, 1, 0); __builtin_amdgcn_sched_group_barrier(0x002, AT_VPM, 0); }
            SBAR();
            pv_load(VF, vbb + b * AT_BUF);
            if (__any(alpha < 1.f)) {
                if (hi == 0) al_l[r32] = alpha;
                LDS_WAIT();
#pragma unroll
                for (int r = 0; r < 16; ++r) { const float a = al_l[crow(r, hi)];
#pragma unroll
                    for (int d = 0; d < 4; ++d) o[d][r] *= a; }
            }
            pa0 = na0; pa1 = na1;
        }
        if (j + 1 < nst) AT_WRITE(b ^ 1);
        __syncthreads();
    }
    asm volatile("s_waitcnt lgkmcnt(0)" ::: "memory"); SBAR();
    pv_mma(o, VF, pa0, pa1);
#undef AT_LOAD
#undef AT_WRITE
    if (hi == 0) { aux[wid * 32 + r32] = m_reg; aux[256 + wid * 32 + r32] = l_reg; }
    __syncthreads();
    const int pw = wid ^ 4;
    const float mo = aux[pw * 32 + r32], lo = aux[256 + pw * 32 + r32];
    const float Mx = fmaxf(m_reg, mo);
    const float es = __builtin_amdgcn_exp2f((m_reg - Mx) * ATTN_C), eo = __builtin_amdgcn_exp2f((mo - Mx) * ATTN_C);
    const float sc = es / (l_reg * es + lo * eo);
    if (hi == 0) aux[512 + wid * 32 + r32] = sc;
    LDS_WAIT();
    LAS float* ob = (LAS float*)lds + wid * 4096;
#pragma unroll
    for (int r = 0; r < 16; ++r) { const int row = crow(r, hi); const float a = aux[512 + wid * 32 + row];
#pragma unroll
        for (int d = 0; d < 4; ++d) ob[row * 128 + 32 * d + r32] = o[d][r] * a; }
    __syncthreads();
    {
        int l2 = lane; asm volatile("" : "+v"(l2)); const int te = wid * 64 + l2;
        const int row = te >> 2, seg = (te & 3) * 32, w0 = row >> 5, rr = row & 31;
        const LAS f32x4* pa = (const LAS f32x4*)((LAS float*)lds + w0 * 4096 + rr * 128 + seg);
        const LAS f32x4* pb = (const LAS f32x4*)((LAS float*)lds + (w0 + 4) * 4096 + rr * 128 + seg);
        bf16_t* dst = mix + (size_t)(q0 + row) * 2048 + 1024 + h * 128 + seg;
#pragma unroll
        for (int q = 0; q < 4; ++q) { const f32x4 x0 = pa[2 * q] + pb[2 * q], x1 = pa[2 * q + 1] + pb[2 * q + 1];
            float v[8] = {x0.x, x0.y, x0.z, x0.w, x1.x, x1.y, x1.z, x1.w}; *(bf16x8*)(dst + 8 * q) = pack8(v); }
    }
    __syncthreads();
}

__device__ __forceinline__ void gate_item(const Frame& F, int row0, int arow0, int jrow0, int ntj, int g, int c0, const bf16_t* wsg, const float* bsg, const float* SSV, const float* gv, const bf16_t* ZU, bf16_t* US, float* OVS) {
    const int lane = F.lane, r32 = lane & 31, hi = lane >> 5;
    LAS unsigned char* vl = F.lds + F.wave * 8192;
    const int vb = (int)(uintptr_t)vl + v_rd_base(lane);
    bf16x8 vr[8];
    VT_LOAD(vr, ZU + (size_t)jrow0 * 4096 + 2048 + c0, 4096);
    LAS float* rt = (LAS float*)(F.lds + 135168 + F.wave * 512);
    for (int rr = lane; rr < 32 * ntj; rr += 64) { const f32x4* sp = (const f32x4*)(SSV + (size_t)(jrow0 + rr) * 32); f32x4 t = sp[0];
#pragma unroll
        for (int k = 1; k < 8; ++k) t += sp[k];
        rt[rr] = rsq(((t.x + t.y) + (t.z + t.w)) * (1.f / GATE) + EPS); }
    const f32x4 gv0 = *(const f32x4*)(gv + c0 + (lane & 15) * 8), gv1 = *(const f32x4*)(gv + c0 + (lane & 15) * 8 + 4);
    f32x16 o[4];
#pragma unroll
    for (int d = 0; d < 4; ++d)
#pragma unroll
        for (int r = 0; r < 16; ++r) o[d][r] = 0.f;
    for (int jt = 0; jt < ntj; ++jt) {
#pragma unroll
        for (int it = 0; it < 8; ++it) { const float r = rt[32 * jt + 4 * it + (lane >> 4)]; const u32x4 w = __builtin_bit_cast(u32x4, vr[it]);
            float v[8] = {bflo(w.x), bfhi(w.x), bflo(w.y), bfhi(w.y), bflo(w.z), bfhi(w.z), bflo(w.w), bfhi(w.w)};
            v[0] *= r * gv0.x; v[1] *= r * gv0.y; v[2] *= r * gv0.z; v[3] *= r * gv0.w; v[4] *= r * gv1.x; v[5] *= r * gv1.y; v[6] *= r * gv1.z; v[7] *= r * gv1.w;
            vr[it] = pack8(v);
            if (OVS) { float* ov = OVS + (size_t)(32 * jt + 4 * it + (lane >> 4)) * GATE + c0 + (lane & 15) * 8;
                *(f32x4*)ov = (f32x4){v[0], v[1], v[2], v[3]}; *(f32x4*)(ov + 4) = (f32x4){v[4], v[5], v[6], v[7]}; } }
        const bf16_t* ap = wsg + (size_t)(arow0 + r32) * 128 + 32 * jt + 8 * hi;
        const bf16x8 pa0 = *(const bf16x8*)ap, pa1 = *(const bf16x8*)(ap + 16);
        VT_WRITE(vl, vr);
        if (jt + 1 < ntj) VT_LOAD(vr, ZU + (size_t)(jrow0 + 32 * (jt + 1)) * 4096 + 2048 + c0, 4096);
        pv32(o, vb, pa0, pa1);
    }
    LAS float* T = (LAS float*)(F.lds + 65536 + F.wave * 8704);
    u32x4 uu[2][4];
#pragma unroll
    for (int p = 0; p < 2; ++p)
#pragma unroll
        for (int k = 0; k < 4; ++k) { const int idx = lane + 64 * k; uu[p][k] = *(const u32x4*)(ZU + (size_t)(row0 + 16 * p + (idx >> 4)) * 4096 + c0 + 8 * (idx & 15)); }
#pragma unroll
    for (int p = 0; p < 2; ++p) {
#pragma unroll
        for (int rr = 0; rr < 8; ++rr) { const int r = 8 * p + rr, lr = (rr & 3) + 8 * (rr >> 2) + 4 * hi; const float b = bsg[arow0 + 16 * p + lr];
#pragma unroll
            for (int d = 0; d < 4; ++d) T[lr * 136 + 32 * d + r32] = o[d][r] + b; }
#pragma unroll
        for (int k = 0; k < 4; ++k) { const int idx = lane + 64 * k, row = idx >> 4, c8 = idx & 15;
            const f32x4 x0 = *(const LAS f32x4*)(T + row * 136 + 8 * c8), x1 = *(const LAS f32x4*)(T + row * 136 + 8 * c8 + 4); const u32x4 w = uu[p][k];
            float v[8] = {bflo(w.x) * x0.x, bfhi(w.x) * x0.y, bflo(w.y) * x0.z, bfhi(w.y) * x0.w, bflo(w.z) * x1.x, bfhi(w.z) * x1.y, bflo(w.w) * x1.z, bfhi(w.w) * x1.w};
            *(bf16x8*)(US + (size_t)(row0 + 16 * p + row) * 2048 + c0 + 8 * c8) = pack8(v); }
    }
}

#define CONVERT_RANGE(A_, B_, RANK_, NW_) do { \
    LAS float* scr_ = (LAS float*)(F.lds + F.wave * 16640); \
    int ra_ = (A_); asm volatile("" : "+s"(ra_));        \
    const int rb_ = (B_), st_ = (NW_); int it_ = ra_ + (RANK_), base_ = 0; \
    _Pragma("unroll 1") for (int q_ = 0; q_ < 44 && base_ < rb_; ++q_) { \
        const int L_ = q_ < 14 ? 0 : (q_ < 22 ? 1 : (q_ < 36 ? 2 : 3)), r_ = q_ - (q_ < 14 ? 0 : (q_ < 22 ? 14 : (q_ < 36 ? 22 : 36))), e_ = L_ >> 1, odd_ = L_ & 1; \
        const int nmix_ = odd_ ? 2 : 8; \
        const float* W_; bf16_t* WT_; const float* gk_ = nullptr; int K_, N_, mode_ = 0, off_ = 0; \
        if (r_ < 3 || r_ >= 3 + nmix_) { const int f_ = r_ < 3 ? 0 : 1, t_ = r_ < 3 ? r_ : r_ - 3 - nmix_; \
            if (t_ < 2) { W_ = INP((f_ ? 11 : 8) + t_) + (size_t)L_ * DM * FF; WT_ = (bf16_t*)(ws + WS_WGU + (size_t)(L_ * 2 + f_) * SZ_WGU); K_ = DM; N_ = FF; mode_ = 1; off_ = 128 * t_; gk_ = INP(f_ ? 7 : 5) + (size_t)L_ * DM; } \
            else { W_ = INP(f_ ? 13 : 10) + (size_t)L_ * FF * DM; WT_ = (bf16_t*)(ws + WS_WD + (size_t)(L_ * 2 + f_) * SZ_WD); K_ = FF; N_ = DM; } } \
        else if (!odd_) { const int m_ = r_ - 3; \
            if (m_ == 0) { W_ = INP(14) + (size_t)e_ * DM * EVIN; WT_ = (bf16_t*)(ws + WS_EWIN + e_ * SZ_EWIN); K_ = DM; N_ = EVIN; gk_ = INP(6) + (size_t)L_ * DM; } \
            else if (m_ == 1) { W_ = INP(17) + (size_t)e_ * QL * 1536; WT_ = (bf16_t*)(ws + WS_EWQB + e_ * SZ_EWQB); K_ = QL; N_ = 1536; } \
            else if (m_ == 2) { W_ = INP(18) + (size_t)e_ * KVL * 2048; WT_ = (bf16_t*)(ws + WS_EWKVB + e_ * SZ_EWKVB); K_ = KVL; N_ = 2048; } \
            else if (m_ < 7) { const int g_ = m_ - 3; W_ = INP(23) + (size_t)(e_ * 4 + g_) * 256 * 256; WT_ = (bf16_t*)(ws + WS_EPOOLW + e_ * SZ_EPOOLW); K_ = 256; N_ = 256; off_ = g_ * 256; } \
            else { W_ = INP(25) + (size_t)e_ * 2048 * 2048; WT_ = (bf16_t*)(ws + WS_EWOUT + e_ * SZ_SQ); K_ = 2048; N_ = 2048; } } \
        else { const int m_ = r_ - 3; \
            if (m_ == 0) { W_ = INP(26) + (size_t)e_ * DM * 4096; WT_ = (bf16_t*)(ws + WS_OWIN + e_ * SZ_OWIN); K_ = DM; N_ = 4096; gk_ = INP(6) + (size_t)L_ * DM; } \
            else { W_ = INP(30) + (size_t)e_ * 2048 * 2048; WT_ = (bf16_t*)(ws + WS_OWOUT + e_ * SZ_SQ); K_ = 2048; N_ = 2048; } } \
        const int nitems_ = (K_ / 64) * (N_ / 64); \
        const int end_ = (base_ + nitems_ < rb_) ? base_ + nitems_ : rb_; \
        if (it_ < end_) { \
            const RmAny rm_{mode_, off_}; \
            f32x4 vA_[16], vB_[16]; \
            _Pragma("unroll") for (int z_ = 0; z_ < 16; ++z_) vB_[z_] = (f32x4){0.f, 0.f, 0.f, 0.f};        \
            tr_load(vA_, W_, N_, it_ - base_, F.lane); \
            if (it_ + st_ < end_) tr_load(vB_, W_, N_, it_ + st_ - base_, F.lane); \
            while (it_ < end_) { \
                tr_to_lds(vA_, scr_, F.lane); \
                if (it_ + 2 * st_ < end_) tr_load(vA_, W_, N_, it_ + 2 * st_ - base_, F.lane); \
                tr_emit(K_, N_, WT_, rm_, scr_, it_ - base_, F.lane, gk_); \
                it_ += st_; \
                if (it_ >= end_) break; \
                tr_to_lds(vB_, scr_, F.lane); \
                if (it_ + 2 * st_ < end_) tr_load(vB_, W_, N_, it_ + 2 * st_ - base_, F.lane); \
                tr_emit(K_, N_, WT_, rm_, scr_, it_ - base_, F.lane, gk_); \
                it_ += st_; \
            } } \
        base_ += nitems_; \
    } } while (0)

template <int U> __device__ __forceinline__ void cache_convert(const float* src, bf16_t* dst, int W, size_t i0, size_t i1, int rank, int nthr) {
    const size_t per = (size_t)PAST * W, dper = (size_t)LKS * W;
    for (size_t b = i0 + rank; b < i1; b += (size_t)U * nthr) {
        f32x4 x0[U], x1[U];
#pragma unroll
        for (int u = 0; u < U; ++u) { const size_t i = b + (size_t)u * nthr; if (i < i1) { x0[u] = __builtin_nontemporal_load((const f32x4*)(src + i * 8)); x1[u] = __builtin_nontemporal_load((const f32x4*)(src + i * 8 + 4)); } }
#pragma unroll
        for (int u = 0; u < U; ++u) { const size_t i = b + (size_t)u * nthr; if (i < i1) { const size_t el = i * 8; const int s = (int)(el / per); const size_t rem = el - (size_t)s * per;
            float v[8] = {x0[u].x, x0[u].y, x0[u].z, x0[u].w, x1[u].x, x1[u].y, x1[u].z, x1[u].w}; *(bf16x8*)(dst + (size_t)s * dper + rem) = pack8(v); } }
    }
}

constexpr int LAST_SID = 1 + 11 * 8 + 3;
__global__ void __launch_bounds__(NTHR, 2) fwd(Args a) {
    extern __shared__ __attribute__((aligned(16))) unsigned char lds_raw[];
    LAS unsigned char* const LDSP = (LAS unsigned char*)lds_raw;
    const int wave0 = __builtin_amdgcn_readfirstlane((int)threadIdx.x >> 6);
    volatile LAS unsigned* MISC = (volatile LAS unsigned*)(LDSP + MISC_OFF);
    if (threadIdx.x < 64) MISC[threadIdx.x] = 0u;
    __syncthreads();
    unsigned char* const ws0 = a.ws;
    const bool one_launch = (a.hi - a.lo) > 1;
    XcdBarrier bar; bar.bar = (unsigned*)(ws0 + WS_CTL) + CW_BAR; bar.x = 0; bar.st = nullptr;
    if (one_launch) bar = xcd_barrier_post((unsigned*)(ws0 + WS_CTL) + CW_BAR, MISC + 8);
#define SITE_PTRS GAS unsigned char* ws_ = (GAS unsigned char*)ws0; asm volatile("" : "+s"(ws_)); unsigned char* const ws = (unsigned char*)ws_; GAS float* X_ = (GAS float*)a.out; asm volatile("" : "+s"(X_)); float* const X = (float*)X_;     \
    float* const tab = (float*)(ws + WS_TAB); bf16_t* const H = (bf16_t*)(ws + WS_H); bf16_t* const PART = (bf16_t*)(ws + WS_PART); bf16_t* const XB = (bf16_t*)(ws + WS_XB); (void)XB; float* const RS = (float*)(ws + WS_H); (void)RS; float* const SSP = (float*)(ws + WS_H + 65536); (void)SSP;        (void)tab; (void)H; (void)PART;
#define IN(s) (a.lo <= (s) && (s) < a.hi)
#define EVT(k) ((unsigned*)(ws + WS_CTL) + CW_EVT + 64 * (17 * (k)))
#define EVX(k) ((unsigned*)(ws + WS_CTL) + CW_EVT + 64 * (17 * (k) + 1 + (int)bar.x))
#define GATE(k) Gate{EVT(k), (unsigned)F.G, (unsigned*)(ws + WS_CTL) + CW_BAR + XB_TMO, one_launch ? bar.st : nullptr, -1, 32}
#define GATE_K(k, t) Gate{EVT(k), (unsigned)F.G, (unsigned*)(ws + WS_CTL) + CW_BAR + XB_TMO, one_launch ? bar.st : nullptr, (t), 1 << 30}
#define ARRIVE(k) do { if (one_launch) evt_arrive(EVT(k), EVX(k), threadIdx.x == 0 ? bar.st[0] : 0u); else evt_arrive(EVT(k), nullptr, 0u); } while (0)
#define SEAM(s) do { if (one_launch && (s) != LAST_SID) xcd_barrier(bar); } while (0)

    if (EN_PRO && IN(0)) { SITE_PTRS const Frame F = make_frame(LDSP, wave0); const int gtid = F.vcu * NTHR + F.tid, GT = F.G * NTHR; (void)gtid; (void)GT;
        if (PRO_MASK & 2) for (int idx = gtid; idx < M * 32; idx += GT) { const int row = idx >> 5, i = idx & 31; const int pos = row < MP ? row : PAST + ((row - MP) & 31);
            const float inv = __builtin_amdgcn_exp2f(-(float)i * (13.287712379549449f / 32.f));
            const double rev = (double)pos * (double)inv * 0.15915494309189535; const float fr = (float)(rev - __builtin_rint(rev));
            tab[(size_t)row * 64 + i] = __builtin_amdgcn_cosf(fr); tab[(size_t)row * 64 + 32 + i] = __builtin_amdgcn_sinf(fr); }
        cache_convert<4>(INP(2), (bf16_t*)(ws + WS_CKVS), KVL, 0, (size_t)DB * PAST * KVL / 8, gtid, GT);
        cache_convert<4>(INP(3), (bf16_t*)(ws + WS_KPES), ROPE, 0, (size_t)DB * PAST * ROPE / 8, gtid, GT);
        if (PRO_MASK & 8) for (int o = 0; o < 2; ++o) { const float* src = INP(28) + (size_t)o * 8 * 128 * 128; bf16_t* dst = (bf16_t*)(ws + WS_OWS + o * SZ_OWS);
            for (int idx = gtid; idx < 8 * 128 * 128; idx += GT) { const int j = idx & 127, i = (idx >> 7) & 127; dst[idx] = f2bf(j <= i ? src[idx] : 0.f); } }
        if (PRO_MASK & 8) for (int e = 0; e < 2; ++e) { u32x4* d = (u32x4*)(ws + WS_EWIN + e * SZ_EWIN + (size_t)EVIN * DM * 2);
            for (int i = gtid; i < (EVINP - EVIN) * DM * 2 / 16; i += GT) d[i] = (u32x4){0u, 0u, 0u, 0u}; }
#pragma unroll 1
        for (int rg = 0; rg < 12; ++rg) { const int ra = a.plan[24 + 2 * rg], rb = a.plan[25 + 2 * rg]; if (ra < rb) CONVERT_RANGE(ra, rb, F.gw, F.NGW); }
        stat_pass(F, XB, RS, PART, 0.f, INP(0), INP(1), SSP);
        SEAM(0);
    }

    for (int L = 0; L < DEPTH; ++L) {
        for (int part = 0; part < 3; ++part) {
            const int sb = 1 + (L * 3 + part) * 8;
            if (part != 1) {
                const int f = part >> 1;
                if (EN_FFN && IN(sb + 0) && !(L == 0 && part == 0)) { SITE_PTRS const Frame F = make_frame(LDSP, wave0); const int gtid = F.vcu * NTHR + F.tid, GT = F.G * NTHR; (void)gtid; (void)GT; if (F.G == 256) stat_pass2(F, XB, RS, PART, part == 0 ? 0.5f : 1.0f, SSP); else stat_pass(F, XB, RS, PART, part == 0 ? 0.5f : 1.0f, nullptr, nullptr, SSP); ARRIVE(L * 3 + part); }
                if (EN_FFN && IN(sb + 1)) { SITE_PTRS const Frame F = make_frame(LDSP, wave0); const int gtid = F.vcu * NTHR + F.tid, GT = F.G * NTHR; (void)gtid; (void)GT;
                    pg8::Gemm g{XB, (const bf16_t*)(ws + WS_WGU + (size_t)(L * 2 + f) * SZ_WGU), M, 2 * FF, DM, DM, DM, 0};
                    pg8::StaticOrder S; S.init(M, 2 * FF, F.G, (int)blockIdx.x, DM);
                    pg8::EpiSwiGLU E{(bf16_t*)(ws + WS_ACT), FF, RS, (LAS float*)(F.lds + AUX_OFF + 4096)};
                    pg8::gemm_phase<pg8::EpiSwiGLU, pg8::StaticOrder>(F.lds, g, S, E, F.tid, (L == 0 && part == 0) ? Gate{nullptr, 0u, nullptr, nullptr, -1, 32} : GATE(L * 3 + part));
                    { const int k = 3 * L + (part ? 2 : 0), c = (int)blockIdx.x;
                      if (c >= 48) CONVERT_RANGE(a.plan[k], a.plan[12 + k], (c - 48) * 8 + F.wave, 208 * 8); }
                    SEAM(sb + 1);
                }
                if (EN_FFN && IN(sb + 2)) { SITE_PTRS const Frame F = make_frame(LDSP, wave0); const int gtid = F.vcu * NTHR + F.tid, GT = F.G * NTHR; (void)gtid; (void)GT;
                    pg8::Gemm g{(const bf16_t*)(ws + WS_ACT), (const bf16_t*)(ws + WS_WD + (size_t)(L * 2 + f) * SZ_WD), M, DM, FF, FF, FF, 0};
                    pg8::SplitOrder S; S.init(DM, F.G, (int)blockIdx.x, FF);
                    pg8::EpiResid E{XB, DM, 0.5f, PART, FF / 64, (L == DEPTH - 1 && part == 2) ? X : nullptr, SSP};
                    pg8::gemm_phase<pg8::EpiResid, pg8::SplitOrder>(F.lds, g, S, E, F.tid);
                    SEAM(sb + 2);
                }
            } else {
                if (EN_FFN && IN(sb + 0)) { SITE_PTRS const Frame F = make_frame(LDSP, wave0); const int gtid = F.vcu * NTHR + F.tid, GT = F.G * NTHR; (void)gtid; (void)GT; if (F.G == 256) stat_pass2(F, XB, RS, PART, 0.5f, SSP); else stat_pass(F, XB, RS, PART, 0.5f, nullptr, nullptr, SSP); ARRIVE(L * 3 + 1); }
                const int e = L >> 1;
                if ((L & 1) == 0) {
#define Z ((float*)(ws + WS_Z))
#define POOLED ((bf16_t*)(ws + WS_POOLED))
#define QAN ((bf16_t*)(ws + WS_QAN))
#define Qb ((bf16_t*)(ws + WS_Q))
#define CKVP ((bf16_t*)(ws + WS_CKVP))
#define KPEP ((bf16_t*)(ws + WS_KPEP))
#define CKVS ((bf16_t*)(ws + WS_CKVS + e * SZ_CKVS))
#define KPES ((bf16_t*)(ws + WS_KPES + e * SZ_KPES))
#define KVP ((bf16_t*)(ws + WS_KVP))
#define KVS ((bf16_t*)(ws + WS_BIG))
#define MIX ((bf16_t*)(ws + WS_MIX))
                    if (EN_EVG && IN(sb + 1)) { SITE_PTRS const Frame F = make_frame(LDSP, wave0); const int gtid = F.vcu * NTHR + F.tid, GT = F.G * NTHR; (void)gtid; (void)GT;
                        pg8::Gemm g{XB, (const bf16_t*)(ws + WS_EWIN + e * SZ_EWIN), M, EVINP, DM, DM, DM, 0};
                        pg8::StaticOrder S; S.init(M, EVINP, F.G, (int)blockIdx.x, DM);
                        pg8::EpiF32 E{Z, EVINP, RS, (LAS float*)(F.lds + AUX_OFF + 4096)};
                        pg8::gemm_phase<pg8::EpiF32, pg8::StaticOrder>(F.lds, g, S, E, F.tid, GATE(L * 3 + 1));
                        { const int k = 3 * L + 1, c = (int)blockIdx.x; if (c >= 68) CONVERT_RANGE(a.plan[k], a.plan[12 + k], (c - 68) * 8 + F.wave, 188 * 8); }
                        SEAM(sb + 1);
                    }
                    if (EN_EVMID && IN(sb + 2)) { SITE_PTRS const Frame F = make_frame(LDSP, wave0); const int gtid = F.vcu * NTHR + F.tid, GT = F.G * NTHR; (void)gtid; (void)GT;
                        const float* gqa = INP(15) + e * QL; const float* gkva = INP(16) + e * KVL; const float* gkpe = INP(22) + e * ROPE;
                        for (int row = F.gw; row < M; row += 2 * F.NGW) {
                            const int row2 = row + F.NGW; const bool two = row2 < M; const int lane = F.lane;
                            f32x4 zq0[2], zq1[2], zk0[2], zk1[2]; float zp[2];
                            zq0[1] = zq1[1] = zk0[1] = zk1[1] = (f32x4){0.f, 0.f, 0.f, 0.f}; zp[1] = 0.f;
#pragma unroll
                            for (int q = 0; q < 2; ++q) if (q == 0 || two) { const float* zr = Z + (size_t)(q ? row2 : row) * EVINP;
                                zq0[q] = *(const f32x4*)(zr + 1024 + 8 * lane); zq1[q] = *(const f32x4*)(zr + 1028 + 8 * lane);
                                zk0[q] = *(const f32x4*)(zr + 1536 + 8 * lane); zk1[q] = *(const f32x4*)(zr + 1540 + 8 * lane); zp[q] = zr[2048 + lane]; }
                            const f32x4 ga0 = *(const f32x4*)(gqa + 8 * lane), ga1 = *(const f32x4*)(gqa + 8 * lane + 4), gb0 = *(const f32x4*)(gkva + 8 * lane), gb1 = *(const f32x4*)(gkva + 8 * lane + 4);
                            const float gpe = gkpe[lane];
#pragma unroll
                            for (int q = 0; q < 2; ++q) if (q == 0 || two) { const int rw = q ? row2 : row;
                                const f32x4 q0 = zq0[q], q1 = zq1[q], k0 = zk0[q], k1 = zk1[q]; const float pr = zp[q];
                                const float rq = rsq(wave_sum((q0.x * q0.x + q0.y * q0.y) + (q0.z * q0.z + q0.w * q0.w) + (q1.x * q1.x + q1.y * q1.y) + (q1.z * q1.z + q1.w * q1.w)) * (1.f / QL) + EPS);
                                const float rk = rsq(wave_sum((k0.x * k0.x + k0.y * k0.y) + (k0.z * k0.z + k0.w * k0.w) + (k1.x * k1.x + k1.y * k1.y) + (k1.z * k1.z + k1.w * k1.w)) * (1.f / KVL) + EPS);
                                const float rp = rsq(wave_sum(pr * pr) * (1.f / ROPE) + EPS);
                                { float v[8] = {q0.x * rq * ga0.x, q0.y * rq * ga0.y, q0.z * rq * ga0.z, q0.w * rq * ga0.w, q1.x * rq * ga1.x, q1.y * rq * ga1.y, q1.z * rq * ga1.z, q1.w * rq * ga1.w};
                                  *(bf16x8*)(QAN + (size_t)rw * QL + 8 * lane) = pack8(v); }
                                const f32x4 c0 = {k0.x * rk * gb0.x, k0.y * rk * gb0.y, k0.z * rk * gb0.z, k0.w * rk * gb0.w}, c1 = {k1.x * rk * gb1.x, k1.y * rk * gb1.y, k1.z * rk * gb1.z, k1.w * rk * gb1.w};
                                const float pn = pr * rp * gpe; const float other = xor32_other(pn, lane);
                                const float cs = tab[(size_t)rw * 64 + (lane & 31)], sn = tab[(size_t)rw * 64 + 32 + (lane & 31)];
                                const float pe = lane < 32 ? pn * cs - other * sn : other * sn + pn * cs;
                                float* oc; float* op; bf16_t* bc; bf16_t* bp;
                                if (rw < MP) { oc = X + O_CKVP + ((size_t)e * MP + rw) * KVL; op = X + O_KPEP + ((size_t)e * MP + rw) * ROPE; bc = CKVP + (size_t)rw * KVL; bp = KPEP + (size_t)rw * ROPE; }
                                else { const int sr = rw - MP, s = sr >> 5, i = sr & 31; oc = X + O_CKVS + ((size_t)e * MS + sr) * KVL; op = X + O_KPES + ((size_t)e * MS + sr) * ROPE;
                                       bc = CKVS + ((size_t)s * LKS + PAST + i) * KVL; bp = KPES + ((size_t)s * LKS + PAST + i) * ROPE; }
                                *(f32x4*)(oc + 8 * lane) = c0; *(f32x4*)(oc + 8 * lane + 4) = c1;
                                { float v[8] = {c0.x, c0.y, c0.z, c0.w, c1.x, c1.y, c1.z, c1.w}; *(bf16x8*)(bc + 8 * lane) = pack8(v); }
                                op[lane] = pe; bp[lane] = f2bf(pe);
                            }
                        }
                        const float* hist = INP(4) + (size_t)e * DB * 15 * POOLD;
                        for (int it = F.vcu; it < (M / 16) * 2; it += F.G) {
                            const int rb = it >> 1, col = (it & 1) * 512 + F.tid, gq = col >> 8;
                            const int row0 = rb * 16; const bool prm = row0 < MP;
                            const int seq0 = prm ? 0 : MP + ((row0 - MP) & ~31);
                            const int l0 = row0 - seq0; const int s = prm ? 0 : (row0 - MP) >> 5;
                            const float* hs = hist + (size_t)s * 15 * POOLD + col;
                            const float* zc = Z + (size_t)seq0 * EVINP + col; bf16_t* pc = POOLED + (size_t)seq0 * POOLD + col;
                            if (gq == 0) pool16<2>(zc, hs, pc, l0, prm); else if (gq == 1) pool16<4>(zc, hs, pc, l0, prm); else if (gq == 2) pool16<8>(zc, hs, pc, l0, prm); else pool16<16>(zc, hs, pc, l0, prm);
                        }
                        for (int idx = gtid; idx < 33 * 15 * POOLD; idx += GT) { const int col = idx & 1023, j = (idx >> 10) % 15, sq = idx / (15 * POOLD);
                            if (sq == 0) X[O_POOLP + ((size_t)e * 15 + j) * POOLD + col] = Z[(size_t)(MP - 15 + j) * EVINP + col];
                            else { const int s = sq - 1; X[O_POOLS + (((size_t)e * DB + s) * 15 + j) * POOLD + col] = Z[(size_t)(MP + 32 * s + 17 + j) * EVINP + col]; } }
                        SEAM(sb + 2);
                    }
                    if (EN_EVG && IN(sb + 3)) { SITE_PTRS const Frame F = make_frame(LDSP, wave0); const int gtid = F.vcu * NTHR + F.tid, GT = F.G * NTHR; (void)gtid; (void)GT;
                        { pg8::Gemm g{POOLED, (const bf16_t*)(ws + WS_EPOOLW + e * SZ_EPOOLW), M, 1024, 256, 1024, 256, 512};
                          pg8::StaticOrder S; S.init(M, 1024, F.G, (int)((blockIdx.x + 144) % F.G), 256);
                          pg8::EpiBf16<0> E{MIX, 2048, 0, INP(24) + e * POOLD, nullptr, nullptr, nullptr};
                          pg8::gemm_phase<pg8::EpiBf16<0>, pg8::StaticOrder>(F.lds, g, S, E, F.tid); }
                        { pg8::Gemm g{QAN, (const bf16_t*)(ws + WS_EWQB + e * SZ_EWQB), M, 1536, QL, QL, QL, 0};
                          pg8::StaticOrder S; S.init(M, 1536, F.G, (int)((blockIdx.x + 216) % F.G), QL);
                          pg8::EpiBf16<0> E{Qb, 1536, 0, nullptr, nullptr, nullptr, nullptr};
                          pg8::gemm_phase<pg8::EpiBf16<0>, pg8::StaticOrder>(F.lds, g, S, E, F.tid); }
                        { pg8::Gemm g{CKVP, (const bf16_t*)(ws + WS_EWKVB + e * SZ_EWKVB), MP, 2048, KVL, KVL, KVL, 0};
                          pg8::StaticOrder S; S.init(MP, 2048, F.G, (int)blockIdx.x, KVL);
                          pg8::EpiKV E{KVP, 2048, INP(21) + e * NOPE, (LAS float*)(F.lds + AUX_OFF)};
                          pg8::gemm_phase<pg8::EpiKV, pg8::StaticOrder>(F.lds, g, S, E, F.tid); }
                        { pg8::Gemm g{CKVS, (const bf16_t*)(ws + WS_EWKVB + e * SZ_EWKVB), MKS, 2048, KVL, KVL, KVL, 0};
                          pg8::StaticOrder S; S.init(MKS, 2048, F.G, (int)blockIdx.x, KVL);
                          pg8::EpiKV E{KVS, 2048, INP(21) + e * NOPE, (LAS float*)(F.lds + AUX_OFF)};
                          pg8::gemm_phase<pg8::EpiKV, pg8::StaticOrder>(F.lds, g, S, E, F.tid); }
                        SEAM(sb + 3);
                    }
                    if (EN_ATTN && IN(sb + 5)) { SITE_PTRS const Frame F = make_frame(LDSP, wave0); const int gtid = F.vcu * NTHR + F.tid, GT = F.G * NTHR; (void)gtid; (void)GT;
                        const float* gqn = INP(19) + e * NOPE; const float* gqp = INP(20) + e * ROPE;
                        const int q4 = F.vcu & 3, sp = q4 == 0 ? 0 : (q4 == 3 ? 2 : 1);
#pragma unroll 1
                        for (int ph = 0; ph < 3; ++ph) {
                            if (ph == sp) { AttnUnit U; const int s = F.vcu & 31; U.qrow0 = MP + 32 * s; U.h = F.vcu >> 5; U.ntiles = LKS / 32; U.kv = KVS + (size_t)s * LKS * 2048; U.kpe = KPES + (size_t)s * LKS * ROPE;
                                attn_unit(F, U, Qb, tab, gqn, gqp, MIX); }
                            else { const int half = ph - (ph > sp ? 1 : 0), pr = F.vcu & 31;
                                attn_unit128(F, F.vcu >> 5, half ? 63 - pr : pr, Qb, KVP, KPEP, tab, gqn, gqp, MIX); }
                            if (L == 0 && ph == 0) {
                                const size_t n1 = (size_t)DB * PAST * KVL / 8, n2 = (size_t)DB * PAST * ROPE / 8;
                                cache_convert<8>(INP(2) + (size_t)DB * PAST * KVL, (bf16_t*)(ws + WS_CKVS + SZ_CKVS), KVL, n1 * F.vcu / F.G, n1 * (F.vcu + 1) / F.G, F.tid, NTHR);
                                cache_convert<8>(INP(3) + (size_t)DB * PAST * ROPE, (bf16_t*)(ws + WS_KPES + SZ_KPES), ROPE, n2 * F.vcu / F.G, n2 * (F.vcu + 1) / F.G, F.tid, NTHR); }
                        }
                        ARRIVE(12 + e);
                    }
                    if (EN_EVG && IN(sb + 6)) { SITE_PTRS const Frame F = make_frame(LDSP, wave0); const int gtid = F.vcu * NTHR + F.tid, GT = F.G * NTHR; (void)gtid; (void)GT;
                        pg8::Gemm g{MIX, (const bf16_t*)(ws + WS_EWOUT + e * SZ_SQ), M, DM, 2048, 2048, 2048, 0};
                        pg8::SplitOrder S; S.init(DM, F.G, (int)blockIdx.x, 2048);
                        pg8::EpiResid E{XB, DM, 1.0f, PART, 2048 / 64, nullptr, SSP};
                        pg8::gemm_phase<pg8::EpiResid, pg8::SplitOrder>(F.lds, g, S, E, F.tid, GATE_K(12 + e, 14));
                        SEAM(sb + 6);
                    }
                } else {
#define ZO ((bf16_t*)(ws + WS_Z))
#define VN ((bf16_t*)(ws + WS_VN))
#define US ((bf16_t*)(ws + WS_US))
                    if (EN_ODDG && IN(sb + 1)) { SITE_PTRS const Frame F = make_frame(LDSP, wave0); const int gtid = F.vcu * NTHR + F.tid, GT = F.G * NTHR; (void)gtid; (void)GT;
                        pg8::Gemm g{XB, (const bf16_t*)(ws + WS_OWIN + e * SZ_OWIN), M, 4096, DM, DM, DM, 0};
                        pg8::StaticOrder S; S.init(M, 4096, F.G, (int)blockIdx.x, DM);
                        pg8::EpiBf16<1> E{ZO, 4096, 0, nullptr, RS, (LAS float*)(F.lds + AUX_OFF + 4096), (float*)(ws + WS_H + 2097152)};
                        pg8::gemm_phase<pg8::EpiBf16<1>, pg8::StaticOrder>(F.lds, g, S, E, F.tid, GATE(L * 3 + 1));
                        { const int k = 3 * L + 1, c = (int)blockIdx.x; if (c >= 64) CONVERT_RANGE(a.plan[k], a.plan[12 + k], (c - 64) * 8 + F.wave, 192 * 8); }
                        SEAM(sb + 1);
                    }
                    if (EN_GATE && IN(sb + 5)) { SITE_PTRS const Frame F = make_frame(LDSP, wave0); const int gtid = F.vcu * NTHR + F.tid, GT = F.G * NTHR; (void)gtid; (void)GT;
                        const bf16_t* wsb = (const bf16_t*)(ws + WS_OWS + e * SZ_OWS); const float* bs = INP(29) + (size_t)e * 8 * 128;
                        const float* SSV = (const float*)(ws + WS_H + 2097152); const float* gv = INP(27) + (size_t)e * GATE;
                        for (int id = F.gw; id < 64 * 8 * 2 * 2; id += F.NGW) {
                            const int k = id & 1, rest = id >> 1, ch = rest & 1, g = (rest >> 1) & 7, n = rest >> 4;
#pragma unroll 1
                            for (int half = 0; half < 2; ++half) { const int ib = half ? 3 - k : k;
                                gate_item(F, 128 * n + 32 * ib, 32 * ib, 128 * n, ib + 1, g, 256 * g + 128 * ch, wsb + (size_t)g * 128 * 128, bs + g * 128, SSV, gv, ZO, US, nullptr); }
                        }
                        for (int id = F.gw; id < DB * 8 * 2; id += F.NGW) {
                            const int ch = id & 1, g = (id >> 1) & 7, s = id >> 4;
                            gate_item(F, MP + 32 * s, 0, MP + 32 * s, 1, g, 256 * g + 128 * ch, wsb + (size_t)g * 128 * 128, bs + g * 128, SSV, gv, ZO, US, X + O_VS + ((size_t)e * MS + 32 * s) * GATE);
                        }
                        SEAM(sb + 5);
                    }
                    if (EN_ODDG && IN(sb + 6)) { SITE_PTRS const Frame F = make_frame(LDSP, wave0); const int gtid = F.vcu * NTHR + F.tid, GT = F.G * NTHR; (void)gtid; (void)GT;
                        pg8::Gemm g{US, (const bf16_t*)(ws + WS_OWOUT + e * SZ_SQ), M, DM, 2048, 2048, 2048, 0};
                        pg8::SplitOrder S; S.init(DM, F.G, (int)blockIdx.x, 2048);
                        pg8::EpiResid E{XB, DM, 1.0f, PART, 2048 / 64, nullptr, SSP};
                        pg8::gemm_phase<pg8::EpiResid, pg8::SplitOrder>(F.lds, g, S, E, F.tid);
                        SEAM(sb + 6);
                    }
                }
            }
        }
    }
    if (IN(LAST_SID)) { SITE_PTRS const Frame F = make_frame(LDSP, wave0);
        for (int row = MP + F.gw; row < M; row += F.NGW) {
            const u32x2* xr = (const u32x2*)(XB + (size_t)row * DM) + F.lane; f32x4* yr = (f32x4*)(X + (size_t)row * DM) + F.lane;
            const u32x2* pr = (const u32x2*)(PART + (size_t)(row - MP) * DM) + F.lane;
#pragma unroll
            for (int j = 0; j < 8; ++j) { f32x4 t = {0.f, 0.f, 0.f, 0.f};
#pragma unroll
                for (int sl = 0; sl < 8; ++sl) t += bf4(pr[(size_t)sl * (1024 * 2048 / 4) + 64 * j]);
                yr[64 * j] = bf4(xr[64 * j]) + t * 0.5f; }
        }
    }
#undef IN
#undef SEAM
#undef Z
#undef POOLED
#undef QAN
#undef Qb
#undef CKVP
#undef KPEP
#undef CKVS
#undef KPES
#undef KVP
#undef KVS
#undef MIX
#undef ZO
#undef VN
#undef US
}

extern "C" void kernel_launch(void* const* d_in, const int* in_sizes, int n_in, void* d_out, int out_size, void* d_ws, size_t ws_size, hipStream_t stream) {
    static int grid = 0;
    if (grid == 0) {
        if (n_in != 31 || out_size != (int)O_END || ws_size < WS_END) { fprintf(stderr, "kernel_launch: unexpected shapes: n_in %d out %d ws %zu (need %zu)\n", n_in, out_size, ws_size, (size_t)WS_END); grid = -1; return; }
        int dev = 0, cus = 0;
        if (hipGetDevice(&dev) != hipSuccess || hipDeviceGetAttribute(&cus, hipDeviceAttributeMultiprocessorCount, dev) != hipSuccess) { grid = -1; return; }
        if (hipFuncSetAttribute((const void*)fwd, hipFuncAttributeMaxDynamicSharedMemorySize, LDS_BYTES) != hipSuccess) { fprintf(stderr, "kernel_launch: hipFuncSetAttribute failed\n"); grid = -1; return; }
        int per_cu = 0; (void)hipOccupancyMaxActiveBlocksPerMultiprocessor(&per_cu, (const void*)fwd, NTHR, LDS_BYTES); (void)hipGetLastError();
        grid = cus;
        if (grid != 256) fprintf(stderr, "kernel_launch: %d CUs (built for 256)\n", grid);
    }
    if (grid < 0) return;
    (void)hipMemsetAsync((char*)d_ws + WS_CTL, 0, CTL_BYTES, stream);
    Args a{};
    for (int i = 0; i < 31; ++i) a.in[i] = (const float*)d_in[i];
    a.out = (float*)d_out; a.ws = (unsigned char*)d_ws;
    {
        static const int slot[12][2] = {{5632, 12288}, {12288, 18304}, {18304, 24960}, {25120, 31776}, {31776, 37920}, {37920, 44576}, {45088, 51744}, {51744, 57760}, {57760, 64416}, {64576, 71232}, {71232, 77376}, {77376, 78912}};
        static const int pro[12][2] = {{0, 5632}, {24960, 25120}, {44576, 45088}, {64416, 64576}, {0, 0}, {0, 0}, {0, 0}, {0, 0}, {0, 0}, {0, 0}, {0, 0}, {0, 0}};
        for (int k = 0; k < 12; ++k) { a.plan[k] = slot[k][0]; a.plan[12 + k] = slot[k][1]; a.plan[24 + 2 * k] = pro[k][0]; a.plan[25 + 2 * k] = pro[k][1]; } }
#if MK_PER_STEP
    for (int s = 0; s <= LAST_SID; ++s) {
        if (s > 0) { const int q = (s - 1) / 8, k = (s - 1) % 8, part = q % 3, L = q / 3;
            if (part != 1) { if (k > 2 && s != LAST_SID) continue; } else if ((L & 1) == 0) { if (k == 4 || k > 6) continue; } else { if (k == 2 || k == 3 || k == 4 || k > 6) continue; } }
        a.lo = s; a.hi = s + 1;
        hipLaunchKernelGGL(fwd, dim3(grid), dim3(NTHR), LDS_BYTES, stream, a);
    }
#else
    a.lo = 0; a.hi = LAST_SID + 1;
    hipLaunchKernelGGL(fwd, dim3(grid), dim3(NTHR), LDS_BYTES, stream, a);
#endif
    const hipError_t le = hipPeekAtLastError();
    if (le != hipSuccess) fprintf(stderr, "kernel_launch: launch failed: %s\n", hipGetErrorName(le));
}
```

```cpp
#include <hip/hip_runtime.h>
#include <cstdio>
#include <cstdint>

#ifndef MK_PER_STEP
#define MK_PER_STEP 0
#endif
#ifndef PRO_MASK
#define PRO_MASK 0xffff
#endif
#ifndef EN_PRO
#define EN_PRO 1
#define EN_FFN 1
#define EN_EVG 1
#define EN_EVMID 1
#define EN_ATTN 1
#define EN_ODDG 1
#define EN_ODDMID 1
#define EN_GATE 1
#endif

#define GAS __attribute__((address_space(1)))
#define LAS __attribute__((address_space(3)))
typedef unsigned short bf16_t;
typedef short bf16x8 __attribute__((ext_vector_type(8)));
typedef short s16x4 __attribute__((ext_vector_type(4)));
typedef float f32x4 __attribute__((ext_vector_type(4)));
typedef float f32x2 __attribute__((ext_vector_type(2)));
typedef float f32x16 __attribute__((ext_vector_type(16)));
typedef unsigned u32x4 __attribute__((ext_vector_type(4)));
typedef unsigned u32x2 __attribute__((ext_vector_type(2)));

constexpr int DM = 2048, SEQ = 8192, DEPTH = 4, DB = 32, DS = 32, PAST = 2048, FF = 5632;
constexpr int MP = SEQ, MS = DB * DS, M = MP + MS;
constexpr int LKS = PAST + DS, MKS = DB * LKS;
constexpr int POOLD = 1024, QL = 512, KVL = 512, ROPE = 64, NOPE = 128, VH = 128, QKH = 192, NH = 8;
constexpr int EVIN = 2112, EVINP = 2304, GATE = 2048;
constexpr float EPS = 1e-6f;
constexpr float ATTN_C = 0.07216878364870322f * 1.4426950408889634f;

constexpr size_t O_YP = 0, O_YS = 16777216, O_CKVP = 18874368, O_KPEP = 27262976, O_POOLP = 28311552, O_CKVS = 28342272, O_KPES = 29390848, O_POOLS = 29521920, O_VS = 30504960, O_END = 34699264;

constexpr size_t al256(size_t x) { return (x + 255) / 256 * 256; }
constexpr size_t WS_CTL = 0, CTL_BYTES = 1u << 20;
constexpr size_t WS_TAB = WS_CTL + CTL_BYTES;
constexpr size_t WS_WGU = WS_TAB + (size_t)M * 64 * 4;
constexpr size_t SZ_WGU = (size_t)2 * FF * DM * 2;
constexpr size_t WS_WD = WS_WGU + 8 * SZ_WGU;
constexpr size_t SZ_WD = (size_t)DM * FF * 2;
constexpr size_t WS_EWIN = WS_WD + 8 * SZ_WD;
constexpr size_t SZ_EWIN = (size_t)EVINP * DM * 2;
constexpr size_t WS_EWQB = WS_EWIN + 2 * SZ_EWIN;
constexpr size_t SZ_EWQB = (size_t)1536 * 512 * 2;
constexpr size_t WS_EWKVB = WS_EWQB + 2 * SZ_EWQB;
constexpr size_t SZ_EWKVB = (size_t)2048 * 512 * 2;
constexpr size_t WS_EPOOLW = WS_EWKVB + 2 * SZ_EWKVB;
constexpr size_t SZ_EPOOLW = (size_t)1024 * 256 * 2;
constexpr size_t WS_EWOUT = WS_EPOOLW + 2 * SZ_EPOOLW;
constexpr size_t SZ_SQ = (size_t)2048 * 2048 * 2;
constexpr size_t WS_OWIN = WS_EWOUT + 2 * SZ_SQ;
constexpr size_t SZ_OWIN = (size_t)4096 * 2048 * 2;
constexpr size_t WS_OWS = WS_OWIN + 2 * SZ_OWIN;
constexpr size_t SZ_OWS = (size_t)8 * 128 * 128 * 2;
constexpr size_t WS_OWOUT = WS_OWS + 2 * SZ_OWS;
constexpr size_t WS_H = WS_OWOUT + 2 * SZ_SQ;
constexpr size_t WS_BIG = WS_H + (size_t)M * DM * 2;
constexpr size_t SZ_BIG = (size_t)MKS * 2048 * 2;
constexpr size_t WS_ACT = WS_BIG, WS_Z = WS_BIG + (size_t)M * FF * 2;
static_assert(WS_Z + (size_t)M * EVINP * 4 <= WS_BIG + SZ_BIG, "overlay");
constexpr size_t WS_POOLED = WS_BIG + SZ_BIG;
constexpr size_t WS_QAN = WS_POOLED + (size_t)M * 1024 * 2;
constexpr size_t WS_Q = WS_QAN + (size_t)M * 512 * 2;
constexpr size_t WS_CKVP = WS_Q + (size_t)M * 1536 * 2;
constexpr size_t WS_KPEP = WS_CKVP + (size_t)MP * 512 * 2;
constexpr size_t WS_CKVS = WS_KPEP + (size_t)MP * 64 * 2;
constexpr size_t SZ_CKVS = (size_t)MKS * 512 * 2;
constexpr size_t WS_KPES = WS_CKVS + 2 * SZ_CKVS;
constexpr size_t SZ_KPES = (size_t)MKS * 64 * 2;
constexpr size_t WS_KVP = WS_KPES + 2 * SZ_KPES;
constexpr size_t WS_MIX = WS_KVP + (size_t)MP * 2048 * 2;
constexpr size_t WS_VN = WS_MIX + (size_t)M * 2048 * 2;
constexpr size_t WS_US = WS_VN + (size_t)M * 2048 * 2;
constexpr size_t WS_PART = WS_US + (size_t)M * 2048 * 2;
constexpr size_t WS_XB = WS_PART + (size_t)8 * 1024 * 2048 * 4;
constexpr size_t WS_END = WS_XB + (size_t)M * DM * 2;

constexpr int CW_BAR = 4096, CW_EVT = 16384;

constexpr int RING_BYTES = 131072, AUX_OFF = RING_BYTES, MISC_OFF = AUX_OFF + 8192, LDS_BYTES = 147456;
constexpr int NWAVES = 8, NTHR = 512;

#define LDS_WAIT() asm volatile("s_waitcnt lgkmcnt(0)" ::: "memory")
#define VM_WAIT() asm volatile("s_waitcnt vmcnt(0)" ::: "memory")
#define SBAR() __builtin_amdgcn_sched_barrier(0)

__device__ __forceinline__ unsigned cvt_pk_bf16(float lo, float hi) { unsigned r; asm volatile("v_cvt_pk_bf16_f32 %0, %1, %2" : "=v"(r) : "v"(lo), "v"(hi)); return r; }
__device__ __forceinline__ float bflo(unsigned w) { return __uint_as_float(w << 16); }
__device__ __forceinline__ float bfhi(unsigned w) { return __uint_as_float(w & 0xffff0000u); }
__device__ __forceinline__ float bf1(short s) { return __uint_as_float(((unsigned)(unsigned short)s) << 16); }
__device__ __forceinline__ bf16_t f2bf(float f) { return (bf16_t)(cvt_pk_bf16(f, 0.f) & 0xffffu); }
template <int CTRL> __device__ __forceinline__ float dpp_f(float v) { return __builtin_bit_cast(float, __builtin_amdgcn_update_dpp(0, __builtin_bit_cast(int, v), CTRL, 0xf, 0xf, true)); }
__device__ __forceinline__ float xor32_sum(float v) { auto r = __builtin_amdgcn_permlane32_swap(__float_as_uint(v), __float_as_uint(v), false, false); return __uint_as_float(r[0]) + __uint_as_float(r[1]); }
__device__ __forceinline__ float xor32_max(float v) { auto r = __builtin_amdgcn_permlane32_swap(__float_as_uint(v), __float_as_uint(v), false, false); return fmaxf(__uint_as_float(r[0]), __uint_as_float(r[1])); }
__device__ __forceinline__ float xor32_other(float v, int lane) { auto r = __builtin_amdgcn_permlane32_swap(__float_as_uint(v), __float_as_uint(v), false, false); return __uint_as_float(lane < 32 ? r[1] : r[0]); }
__device__ __forceinline__ float sum16(float v) {
    v += dpp_f<0xB1>(v);
    v += dpp_f<0x4E>(v);
    v += dpp_f<0x141>(v);
    v += dpp_f<0x140>(v);
    return v;
}
__device__ __forceinline__ float wave_sum(float v) {
    v = sum16(v);
    { auto r = __builtin_amdgcn_permlane16_swap(__float_as_uint(v), __float_as_uint(v), false, false); v = __uint_as_float(r[0]) + __uint_as_float(r[1]); }
    return xor32_sum(v);
}
__device__ __forceinline__ float rsq(float x) { return 1.0f / sqrtf(x); }
__device__ __forceinline__ bf16x8 pack8(const float* v) { u32x4 w; w.x = cvt_pk_bf16(v[0], v[1]); w.y = cvt_pk_bf16(v[2], v[3]); w.z = cvt_pk_bf16(v[4], v[5]); w.w = cvt_pk_bf16(v[6], v[7]); return __builtin_bit_cast(bf16x8, w); }

struct Gate { unsigned* evt; unsigned need; unsigned* tmo; volatile LAS unsigned* st; int tg, pm0; };
__device__ __forceinline__ void evt_arrive(unsigned* e, unsigned* ex, unsigned nloc) {
    asm volatile("s_waitcnt vmcnt(0)" ::: "memory");
    __syncthreads();
    if (threadIdx.x == 0) {
        bool pub = true;
        if (ex) { const unsigned old = __hip_atomic_fetch_add(ex, 1u, __ATOMIC_RELAXED, __HIP_MEMORY_SCOPE_AGENT); pub = (old + 1u == nloc); }
        if (pub) { __builtin_amdgcn_fence(__ATOMIC_RELEASE, "agent"); asm volatile("s_waitcnt vmcnt(0)" ::: "memory");
            (void)__hip_atomic_fetch_add(e, 1u, __ATOMIC_RELAXED, __HIP_MEMORY_SCOPE_AGENT); }
    }
}
__device__ __forceinline__ void evt_wait_one(const Gate& g) {
    const unsigned need = g.st ? g.st[1] : g.need;
    unsigned sp = 0;
    while (__hip_atomic_load(g.evt, __ATOMIC_RELAXED, __HIP_MEMORY_SCOPE_AGENT) < need) { __builtin_amdgcn_s_sleep(1);
        if ((++sp & 255u) == 0u) { if (__hip_atomic_load(g.tmo, __ATOMIC_RELAXED, __HIP_MEMORY_SCOPE_AGENT)) break; if (sp > (1u << 18)) { atomicAdd(g.tmo, 1u); break; } } }
    __builtin_amdgcn_fence(__ATOMIC_ACQUIRE, "agent");
    asm volatile("s_waitcnt vmcnt(0)" ::: "memory");
}

namespace pg8 {
constexpr int BM = 256, BK = 64, HALF = 128, HTB = HALF * BK * 2, STAGE_BYTES = 8 * HTB, NXCD = 8, WGM = 8;
__host__ __device__ __forceinline__ int lds_byte(int r, int c) { const int st = (r >> 4) * 2 + (c >> 5), rr = r & 15, cc = c & 31, ob = rr * 64 + cc * 2; return st * 1024 + (ob ^ (((ob >> 9) & 1) << 5)); }
__host__ __device__ __forceinline__ void stage_rc(int b, int& R, int& C) { const int st = b / 1024, sb = b % 1024, swz = sb ^ (((sb >> 9) & 1) << 5); R = (st >> 1) * 16 + swz / 64; C = (st & 1) * 32 + (swz % 64) / 2; }
__host__ __device__ __forceinline__ int perm32(int rho) { const int n = rho >> 4, i = rho & 15; return 8 * (i >> 2) + 4 * n + (i & 3); }
struct Unit { int pm, pn, kt0, nkt; };
struct Gemm { const bf16_t* A; const bf16_t* Bt; int M, N, K, lda, ldb, apn; };
struct StaticOrder {
    int nM, nN, nwg, G, c, ntk;
    __host__ __device__ void init(int M_, int N_, int G_, int c_, int K_) { nM = M_ / BM; nN = N_ / BM; nwg = nM * nN; G = G_; c = c_; ntk = K_ / BK; }
    __host__ __device__ bool next(int i, Unit& u) const {
        u.kt0 = 0; u.nkt = ntk;
        const long L = (long)i * G + c; if (L >= nwg) return false;
        int wgid = (int)L; { const int q = nwg / NXCD, r = nwg % NXCD, xcd = wgid % NXCD, off = wgid / NXCD; wgid = (xcd < r ? xcd * (q + 1) : r * (q + 1) + (xcd - r) * q) + off; }
        const int nig = WGM * nN, gid = wgid / nig, fm = gid * WGM, gsz = (nM - fm) < WGM ? (nM - fm) : WGM;
        u.pm = fm + ((wgid % nig) % gsz); u.pn = (wgid % nig) / gsz; return true;
    }
    __device__ __forceinline__ void a_ready(const Unit&) const {}
    __device__ __forceinline__ void done(const Unit&) const {}
};
struct SplitOrder {
    StaticOrder so; int c;
    __host__ __device__ void init(int N_, int G_, int c_, int K_) { so.init(8192, N_, G_, c_, K_); c = c_; }
    __host__ __device__ bool next(int i, Unit& u) const {
        if (i == 0) return so.next(0, u);
        if (i > 1) return false;
        const int sub = c & 7, tile = c >> 3; u.pm = 32 + (tile >> 3); u.pn = tile & 7;
        const int b0 = ((so.ntk * sub) / 8 + 1) & ~1, b1 = ((so.ntk * (sub + 1)) / 8 + 1) & ~1; u.kt0 = b0; u.nkt = b1 - b0; return true;
    }
    __device__ __forceinline__ void a_ready(const Unit&) const {}
    __device__ __forceinline__ void done(const Unit&) const {}
};

__device__ __forceinline__ void rl_fetch(const float* R, LAS float* RL, const Unit& u, int wid, int lane, int par) {
    if (wid < 4) __builtin_amdgcn_global_load_lds((const unsigned*)(R + u.pm * BM + wid * 64 + lane), (LAS unsigned*)(RL + par * 256 + wid * 64), 4, 0, 0);
}
struct EpiF32 {
    static constexpr bool PERM = false;
    float* C; int ldc; const float* R; LAS float* RL;
    __device__ __forceinline__ void prefetch(const Unit& u, int wid, int lane, int par) const { rl_fetch(R, RL, u, wid, lane, par); }
    __device__ __forceinline__ void operator()(const f32x4 (&acc)[2][2][4][2], const Unit& u, int wr, int wc, int fr, int fq, int par) const {
        const int row0 = u.pm * BM + wr * 64 + fr, col0 = u.pn * BM + wc * 32 + 4 * fq;
        float rr[2][4];
#pragma unroll
        for (int ai = 0; ai < 2; ++ai)
#pragma unroll
            for (int m = 0; m < 4; ++m) rr[ai][m] = RL[par * 256 + wr * 64 + fr + ai * HALF + m * 16];
        __builtin_amdgcn_sched_barrier(0);
#pragma unroll
        for (int ai = 0; ai < 2; ++ai)
#pragma unroll
            for (int m = 0; m < 4; ++m) { float* rowp = C + (size_t)(row0 + ai * HALF + m * 16) * ldc + col0; const float r = rr[ai][m];
#pragma unroll
                for (int bj = 0; bj < 2; ++bj)
#pragma unroll
                    for (int n = 0; n < 2; ++n) *(f32x4*)(rowp + bj * HALF + n * 16) = acc[ai][bj][m][n] * r; }
    }
};
struct EpiResid {
    static constexpr bool PERM = true;
    bf16_t* XB; int ldc; float scale; bf16_t* P; int ntk; float* Y;
    __device__ __forceinline__ void prefetch(const Unit&, int, int, int) const {}
    float* SSP;
    __device__ __forceinline__ void operator()(const f32x4 (&acc)[2][2][4][2], const Unit& u, int wr, int wc, int fr, int fq, int par) const {
        const int row0 = u.pm * BM + wr * 64 + fr, col0 = u.pn * BM + wc * 32 + 8 * fq;
        if (u.nkt != ntk) {
            bf16_t* Pb = P + (size_t)((u.kt0 * 8) / ntk) * (1024 * 2048) + (size_t)(row0 - 8192) * 2048 + col0;
#pragma unroll
            for (int ai = 0; ai < 2; ++ai)
#pragma unroll
                for (int m = 0; m < 4; ++m)
#pragma unroll
                    for (int bj = 0; bj < 2; ++bj) { const f32x4 t0 = acc[ai][bj][m][0], t1 = acc[ai][bj][m][1]; float v[8] = {t0.x, t0.y, t0.z, t0.w, t1.x, t1.y, t1.z, t1.w};
                        *(bf16x8*)(Pb + (size_t)(ai * HALF + m * 16) * 2048 + bj * HALF) = pack8(v); }
            return;
        }
        u32x4 b[2][4][2];
#pragma unroll
        for (int ai = 0; ai < 2; ++ai)
#pragma unroll
            for (int m = 0; m < 4; ++m)
#pragma unroll
                for (int bj = 0; bj < 2; ++bj) b[ai][m][bj] = *(const u32x4*)(XB + (size_t)(row0 + ai * HALF + m * 16) * ldc + col0 + bj * HALF);
#pragma unroll
        for (int ai = 0; ai < 2; ++ai)
#pragma unroll
            for (int m = 0; m < 4; ++m) { float ss = 0.f;
#pragma unroll
                for (int bj = 0; bj < 2; ++bj) { const u32x4 w = b[ai][m][bj]; const f32x4 t0 = acc[ai][bj][m][0], t1 = acc[ai][bj][m][1];
                    float v[8] = {bflo(w.x) + t0.x * scale, bfhi(w.x) + t0.y * scale, bflo(w.y) + t0.z * scale, bfhi(w.y) + t0.w * scale, bflo(w.z) + t1.x * scale, bfhi(w.z) + t1.y * scale, bflo(w.w) + t1.z * scale, bfhi(w.w) + t1.w * scale};
                    if (Y) { float* yp = Y + (size_t)(row0 + ai * HALF + m * 16) * ldc + col0 + bj * HALF; *(f32x4*)yp = (f32x4){v[0], v[1], v[2], v[3]}; *(f32x4*)(yp + 4) = (f32x4){v[4], v[5], v[6], v[7]}; }
                    else { const bf16x8 o8 = pack8(v); *(bf16x8*)(XB + (size_t)(row0 + ai * HALF + m * 16) * ldc + col0 + bj * HALF) = o8;
                        const u32x4 r4 = __builtin_bit_cast(u32x4, o8);
                        ss += (bflo(r4.x) * bflo(r4.x) + bfhi(r4.x) * bfhi(r4.x)) + (bflo(r4.y) * bflo(r4.y) + bfhi(r4.y) * bfhi(r4.y)) + (bflo(r4.z) * bflo(r4.z) + bfhi(r4.z) * bfhi(r4.z)) + (bflo(r4.w) * bflo(r4.w) + bfhi(r4.w) * bfhi(r4.w)); } }
                if (!Y) {
                    { auto r = __builtin_amdgcn_permlane16_swap(__float_as_uint(ss), __float_as_uint(ss), false, false); ss = __uint_as_float(r[0]) + __uint_as_float(r[1]); }
                    { auto r = __builtin_amdgcn_permlane32_swap(__float_as_uint(ss), __float_as_uint(ss), false, false); ss = __uint_as_float(r[0]) + __uint_as_float(r[1]); }
                    if (fq == 0) SSP[(size_t)(row0 + ai * HALF + m * 16) * 32 + u.pn * 4 + wc] = ss; } }
    }
};
struct EpiSwiGLU {
    static constexpr bool PERM = true;
    bf16_t* O; int ldc; const float* R; LAS float* RL;
    __device__ __forceinline__ void prefetch(const Unit& u, int wid, int lane, int par) const { rl_fetch(R, RL, u, wid, lane, par); }
    __device__ __forceinline__ void operator()(const f32x4 (&acc)[2][2][4][2], const Unit& u, int wr, int wc, int fr, int fq, int par) const {
        const int row0 = u.pm * BM + wr * 64 + fr, col0 = u.pn * HALF + wc * 32 + 8 * fq;
        float rr[2][4];
#pragma unroll
        for (int ai = 0; ai < 2; ++ai)
#pragma unroll
            for (int m = 0; m < 4; ++m) rr[ai][m] = RL[par * 256 + wr * 64 + fr + ai * HALF + m * 16];
        __builtin_amdgcn_sched_barrier(0);
#pragma unroll
        for (int ai = 0; ai < 2; ++ai)
#pragma unroll
            for (int m = 0; m < 4; ++m) {
                float v[8]; const float r = rr[ai][m];
                const f32x2 rc = {-1.4426950408889634f * r, -1.4426950408889634f * r}, r2 = {r * r, r * r};
#pragma unroll
                for (int n = 0; n < 2; ++n)
#pragma unroll
                    for (int h = 0; h < 2; ++h) { const f32x2 g2 = {acc[ai][0][m][n][2 * h], acc[ai][0][m][n][2 * h + 1]}, u2 = {acc[ai][1][m][n][2 * h], acc[ai][1][m][n][2 * h + 1]};
                        const f32x2 ex = g2 * rc; const f32x2 d = (f32x2){__builtin_amdgcn_exp2f(ex.x), __builtin_amdgcn_exp2f(ex.y)} + (f32x2){1.0f, 1.0f};
                        const f32x2 o = ((g2 * u2) * r2) * (f32x2){__builtin_amdgcn_rcpf(d.x), __builtin_amdgcn_rcpf(d.y)};
                        v[n * 4 + 2 * h] = o.x; v[n * 4 + 2 * h + 1] = o.y; }
                *(bf16x8*)(O + (size_t)(row0 + ai * HALF + m * 16) * ldc + col0) = pack8(v); }
    }
};
template <int ACT  > struct EpiBf16 {
    static constexpr bool PERM = true;
    bf16_t* O; int ldc; int col_off; const float* cscale; const float* R; LAS float* RL;
    float* SSV;
    __device__ __forceinline__ void prefetch(const Unit& u, int wid, int lane, int par) const { if (R) rl_fetch(R, RL, u, wid, lane, par); }
    __device__ __forceinline__ void operator()(const f32x4 (&acc)[2][2][4][2], const Unit& u, int wr, int wc, int fr, int fq, int par) const {
        const int row0 = u.pm * BM + wr * 64 + fr, col0 = u.pn * BM + wc * 32 + 8 * fq;
        f32x4 sv[2][2];
#pragma unroll
        for (int bj = 0; bj < 2; ++bj)
#pragma unroll
            for (int n = 0; n < 2; ++n) sv[bj][n] = cscale ? *(const f32x4*)(cscale + col0 + bj * HALF + 4 * n) : (f32x4){1.f, 1.f, 1.f, 1.f};
        float rr[2][4];
#pragma unroll
        for (int ai = 0; ai < 2; ++ai)
#pragma unroll
            for (int m = 0; m < 4; ++m) rr[ai][m] = R ? RL[par * 256 + wr * 64 + fr + ai * HALF + m * 16] : 1.f;
        __builtin_amdgcn_sched_barrier(0);
#pragma unroll
        for (int ai = 0; ai < 2; ++ai)
#pragma unroll
            for (int m = 0; m < 4; ++m) { bf16_t* rowp = O + (size_t)(row0 + ai * HALF + m * 16) * ldc + col_off + col0; const float rs = rr[ai][m]; float ss = 0.f;
#pragma unroll
                for (int bj = 0; bj < 2; ++bj) {
                    float v[8];
#pragma unroll
                    for (int n = 0; n < 2; ++n)
#pragma unroll
                        for (int e = 0; e < 4; ++e) { float x = acc[ai][bj][m][n][e] * rs;
                            if (ACT == 1) { const float t = 0.7978845608028654f * (x + 0.044715f * x * x * x);
                                x = x * __builtin_amdgcn_rcpf(1.0f + __builtin_amdgcn_exp2f(-2.8853900817779268f * t)); }
                            else x *= sv[bj][n][e];
                            v[n * 4 + e] = x; }
                    const bf16x8 o8 = pack8(v); *(bf16x8*)(rowp + bj * HALF) = o8;
                    if (ACT == 1) { const u32x4 r4 = __builtin_bit_cast(u32x4, o8);
                        ss += (bflo(r4.x) * bflo(r4.x) + bfhi(r4.x) * bfhi(r4.x)) + (bflo(r4.y) * bflo(r4.y) + bfhi(r4.y) * bfhi(r4.y)) + (bflo(r4.z) * bflo(r4.z) + bfhi(r4.z) * bfhi(r4.z)) + (bflo(r4.w) * bflo(r4.w) + bfhi(r4.w) * bfhi(r4.w)); } }
                if (ACT == 1 && SSV && u.pn >= 8) {
                    { auto r = __builtin_amdgcn_permlane16_swap(__float_as_uint(ss), __float_as_uint(ss), false, false); ss = __uint_as_float(r[0]) + __uint_as_float(r[1]); }
                    { auto r = __builtin_amdgcn_permlane32_swap(__float_as_uint(ss), __float_as_uint(ss), false, false); ss = __uint_as_float(r[0]) + __uint_as_float(r[1]); }
                    if (fq == 0) SSV[(size_t)(row0 + ai * HALF + m * 16) * 32 + (u.pn - 8) * 4 + wc] = ss; } }
    }
};

struct EpiKV {
    static constexpr bool PERM = true;
    bf16_t* O; int ldc; const float* gain; LAS float* xs;
    __device__ __forceinline__ void prefetch(const Unit&, int, int, int) const {}
    __device__ __forceinline__ void operator()(const f32x4 (&acc)[2][2][4][2], const Unit& u, int wr, int wc, int fr, int fq, int par) const {
        const int row0 = u.pm * BM + wr * 64 + fr, col0 = u.pn * BM + wc * 32 + 8 * fq;
        const f32x4 g0 = *(const f32x4*)(gain + wc * 32 + 8 * fq), g1 = *(const f32x4*)(gain + wc * 32 + 8 * fq + 4);
#pragma unroll
        for (int ai = 0; ai < 2; ++ai)
#pragma unroll
            for (int m = 0; m < 4; ++m) { float ss = 0.f;
#pragma unroll
                for (int n = 0; n < 2; ++n)
#pragma unroll
                    for (int e = 0; e < 4; ++e) ss += acc[ai][0][m][n][e] * acc[ai][0][m][n][e];
                { auto r = __builtin_amdgcn_permlane16_swap(__float_as_uint(ss), __float_as_uint(ss), false, false); ss = __uint_as_float(r[0]) + __uint_as_float(r[1]); }
                { auto r = __builtin_amdgcn_permlane32_swap(__float_as_uint(ss), __float_as_uint(ss), false, false); ss = __uint_as_float(r[0]) + __uint_as_float(r[1]); }
                if (fq == 0) xs[(ai * HALF + wr * 64 + m * 16 + fr) * 4 + wc] = ss; }
#pragma unroll
        for (int ai = 0; ai < 2; ++ai)
#pragma unroll
            for (int m = 0; m < 4; ++m) { float v[8]; const f32x4 a0 = acc[ai][1][m][0], a1 = acc[ai][1][m][1];
                v[0] = a0.x; v[1] = a0.y; v[2] = a0.z; v[3] = a0.w; v[4] = a1.x; v[5] = a1.y; v[6] = a1.z; v[7] = a1.w;
                *(bf16x8*)(O + (size_t)(row0 + ai * HALF + m * 16) * ldc + col0 + HALF) = pack8(v); }
        asm volatile("s_waitcnt lgkmcnt(0)" ::: "memory"); __builtin_amdgcn_s_barrier(); asm volatile("" ::: "memory");
        f32x4 tt[2][4];
#pragma unroll
        for (int ai = 0; ai < 2; ++ai)
#pragma unroll
            for (int m = 0; m < 4; ++m) tt[ai][m] = *(const LAS f32x4*)(xs + (ai * HALF + wr * 64 + m * 16 + fr) * 4);
#pragma unroll
        for (int ai = 0; ai < 2; ++ai)
#pragma unroll
            for (int m = 0; m < 4; ++m) { const f32x4 t = tt[ai][m];
                const float r = __builtin_amdgcn_rsqf(((t.x + t.y) + (t.z + t.w)) * (1.f / 128.f) + 1e-6f);
                bf16_t* rowp = O + (size_t)(row0 + ai * HALF + m * 16) * ldc + col0;
                { float v[8]; const f32x4 a0 = acc[ai][0][m][0], a1 = acc[ai][0][m][1];
                  v[0] = a0.x * r * g0.x; v[1] = a0.y * r * g0.y; v[2] = a0.z * r * g0.z; v[3] = a0.w * r * g0.w; v[4] = a1.x * r * g1.x; v[5] = a1.y * r * g1.y; v[6] = a1.z * r * g1.z; v[7] = a1.w * r * g1.w;
                  *(bf16x8*)rowp = pack8(v); } }
    }
};

template <class Epi, class Sched, bool ALIGN_EPI = true>
__device__ __forceinline__ void gemm_phase(LAS unsigned char* lds, const Gemm g, const Sched& S, const Epi& E, int tid_in, const Gate gate = Gate{nullptr, 0u, nullptr, nullptr, -1, 32}) {
    int tid_ = tid_in; asm volatile("" : "+v"(tid_));
    const int tid = tid_, wid = __builtin_amdgcn_readfirstlane(tid >> 6), lane = tid & 63, wr = wid >> 2, wc = wid & 3, fr = lane & 15, fq = lane >> 4;
    unsigned voffA[2], voffB[2];
#pragma unroll
    for (int i = 0; i < 2; ++i) { int R, C; stage_rc(tid * 16 + i * 8192, R, C); const int Rb = Epi::PERM ? ((R & ~31) + perm32(R & 31)) : R;
        voffA[i] = (unsigned)(R * g.lda + C) * 2u; voffB[i] = (unsigned)(Rb * g.ldb + C) * 2u; }
    const size_t kstep = (size_t)(BK * 2);
    const size_t hsA = (size_t)HALF * g.lda * 2, hsB = (size_t)HALF * g.ldb * 2;
    const size_t tsA = 2 * hsA, tsB = 2 * hsB;
    const unsigned ldsw = (unsigned)wid * 1024u;
    const int aoff = lds_byte(wr * 64 + fr, fq * 8), boff = lds_byte(wc * 32 + fr, fq * 8);
#define PG8_SA(b, h) (((b) * 2 + (h)) * HTB)
#define PG8_SB(b, h) ((4 + (b) * 2 + (h)) * HTB)
#define PG8_STAGE(bufoff, gbase, voff) do { _Pragma("unroll") for (int _i = 0; _i < 2; ++_i) \
        __builtin_amdgcn_global_load_lds((const unsigned*)((const char*)(gbase) + (voff)[_i]), (LAS unsigned*)(lds + (bufoff) + ldsw + _i * 8192), 16, 0, 0); } while (0)
#define PG8_LDA(dst, b, h) do { _Pragma("unroll") for (int m = 0; m < 4; ++m) _Pragma("unroll") for (int k = 0; k < 2; ++k) dst[m][k] = *(const LAS bf16x8*)(lds + PG8_SA(b, h) + aoff + m * 2048 + k * 1024); } while (0)
#define PG8_LDB(dst, b, h) do { _Pragma("unroll") for (int n = 0; n < 2; ++n) _Pragma("unroll") for (int k = 0; k < 2; ++k) dst[n][k] = *(const LAS bf16x8*)(lds + PG8_SB(b, h) + boff + n * 2048 + k * 1024); } while (0)
#define PG8_MMA(ai, bj, At, Bt) do { __builtin_amdgcn_s_setprio(1); _Pragma("unroll") for (int m = 0; m < 4; ++m) _Pragma("unroll") for (int n = 0; n < 2; ++n) _Pragma("unroll") for (int k = 0; k < 2; ++k) \
        acc[ai][bj][m][n] = __builtin_amdgcn_mfma_f32_16x16x32_bf16(Bt[n][k], At[m][k], acc[ai][bj][m][n], 0, 0, 0); __builtin_amdgcn_s_setprio(0); } while (0)
#define PG8_WAIT_V(n) asm volatile("s_waitcnt vmcnt(" #n ")" ::: "memory")
#define PG8_WAIT_L(n) asm volatile("s_waitcnt lgkmcnt(" #n ")" ::: "memory")
#define PG8_BAR __builtin_amdgcn_s_barrier()
#define PG8_SCHED __builtin_amdgcn_sched_barrier(0)
    Unit cur, nxt; int ui = 0;
    if (!S.next(0, cur)) return;
    bool open = (gate.evt == nullptr);
    if (!open && cur.pm >= gate.pm0) { if (tid == 0) evt_wait_one(gate); __syncthreads(); open = true; }
    if (open) E.prefetch(cur, wid, lane, 0);
    f32x4 acc[2][2][4][2];
#pragma unroll
    for (int a = 0; a < 2; ++a)
#pragma unroll
        for (int b = 0; b < 2; ++b)
#pragma unroll
            for (int m = 0; m < 4; ++m)
#pragma unroll
                for (int n = 0; n < 2; ++n) acc[a][b][m][n] = (f32x4){0.f, 0.f, 0.f, 0.f};
    bf16x8 At[4][2], B0[2][2], B1[2][2];
    const char* cA = (const char*)g.A + (size_t)cur.pm * tsA + (size_t)cur.pn * g.apn + (size_t)cur.kt0 * kstep; const char* cB = (const char*)g.Bt + (size_t)cur.pn * tsB + (size_t)cur.kt0 * kstep;
    S.a_ready(cur);
    PG8_STAGE(PG8_SB(0, 0), cB, voffB); PG8_STAGE(PG8_SB(0, 1), cB + hsB, voffB); PG8_STAGE(PG8_SA(0, 0), cA, voffA); PG8_STAGE(PG8_SA(0, 1), cA + hsA, voffA);
    if (wr == 1) PG8_BAR;
    PG8_WAIT_V(2); PG8_BAR;
    PG8_STAGE(PG8_SB(1, 0), cB + kstep, voffB); PG8_STAGE(PG8_SA(1, 0), cA + kstep, voffA); PG8_STAGE(PG8_SB(1, 1), cB + hsB + kstep, voffB);
    PG8_WAIT_V(6); PG8_BAR;
    for (;;) {
        const bool has_next = S.next(ui + 1, nxt);
        const char* nA = has_next ? (const char*)g.A + (size_t)nxt.pm * tsA + (size_t)nxt.pn * g.apn + (size_t)nxt.kt0 * kstep : cA; const char* nB = has_next ? (const char*)g.Bt + (size_t)nxt.pn * tsB + (size_t)nxt.kt0 * kstep : cB;
        const int nt = cur.nkt;
        for (int t = 0; t < nt; t += 2) {
            const bool last = (t == nt - 2);
            const char* a1 = cA + (size_t)(t + 1) * kstep;
            const char* a2 = last ? nA : cA + (size_t)(t + 2) * kstep; const char* b2 = last ? nB : cB + (size_t)(t + 2) * kstep;
            const char* a3 = a2 + kstep; const char* b3 = b2 + kstep;
            if (last && has_next) S.a_ready(nxt);
            const bool gate_now = !open && (gate.tg < 0 ? last : t == gate.tg);
            if (gate_now && tid == 0) evt_wait_one(gate);
            PG8_LDB(B0, 0, 0); PG8_LDB(B1, 0, 1); PG8_SCHED; PG8_LDA(At, 0, 0); PG8_STAGE(PG8_SA(1, 1), a1 + hsA, voffA);
            PG8_WAIT_V(8); PG8_WAIT_L(0); PG8_BAR; PG8_MMA(0, 0, At, B0); PG8_MMA(0, 1, At, B1); PG8_BAR; PG8_SCHED;
            if (gate_now) { E.prefetch(cur, wid, lane, ui & 1); open = true; }
            PG8_LDA(At, 0, 1); PG8_STAGE(PG8_SB(0, 0), b2, voffB); PG8_STAGE(PG8_SB(0, 1), b2 + hsB, voffB); PG8_STAGE(PG8_SA(0, 0), a2, voffA);
            PG8_WAIT_V(8); PG8_WAIT_L(0); PG8_BAR; PG8_MMA(1, 0, At, B0); PG8_MMA(1, 1, At, B1); PG8_BAR; PG8_SCHED;
            PG8_LDB(B0, 1, 0); PG8_LDB(B1, 1, 1); PG8_SCHED; PG8_LDA(At, 1, 0); PG8_STAGE(PG8_SA(0, 1), a2 + hsA, voffA);
            PG8_WAIT_V(8); PG8_WAIT_L(0); PG8_BAR; PG8_MMA(0, 0, At, B0); PG8_MMA(0, 1, At, B1); PG8_BAR; PG8_SCHED;
            PG8_LDA(At, 1, 1); PG8_STAGE(PG8_SB(1, 0), b3, voffB); PG8_STAGE(PG8_SB(1, 1), b3 + hsB, voffB); PG8_STAGE(PG8_SA(1, 0), a3, voffA);
            PG8_WAIT_V(8); PG8_WAIT_L(0); PG8_BAR; PG8_MMA(1, 0, At, B0); PG8_MMA(1, 1, At, B1); PG8_BAR; PG8_SCHED;
        }
        if constexpr (ALIGN_EPI) { if (wr == 0) PG8_BAR; }
        E(acc, cur, wr, wc, fr, fq, ui & 1); S.done(cur);
        if (!has_next) break;
#pragma unroll
        for (int a = 0; a < 2; ++a)
#pragma unroll
            for (int b = 0; b < 2; ++b)
#pragma unroll
                for (int m = 0; m < 4; ++m)
#pragma unroll
                    for (int n = 0; n < 2; ++n) acc[a][b][m][n] = (f32x4){0.f, 0.f, 0.f, 0.f};
        cur = nxt; cA = nA; cB = nB; ++ui;
        E.prefetch(cur, wid, lane, ui & 1);
        if constexpr (ALIGN_EPI) { if (wr == 1) PG8_BAR; }
    }
    PG8_WAIT_V(0);
    if constexpr (!ALIGN_EPI) { if (wr == 0) PG8_BAR; }
    PG8_BAR;
#undef PG8_SA
#undef PG8_SB
#undef PG8_STAGE
#undef PG8_LDA
#undef PG8_LDB
#undef PG8_MMA
#undef PG8_WAIT_V
#undef PG8_WAIT_L
#undef PG8_BAR
#undef PG8_SCHED
}
}

#define XB_TMO      128
#define XB_XCNT(j)  (256  + 64 * (j))
#define XB_XSUB(j)  (1280 + 64 * (j))
#define XB_XGEN(j)  (2304 + 64 * (j))
#define XB_TOP      3328
#define XB_TOPGEN   3392
#define XCD_BAR_WORDS 3456
#define XB_SPIN_CAP (1u << 18)
__device__ __forceinline__ unsigned xb_ld(unsigned* p)              { return __hip_atomic_load(p, __ATOMIC_RELAXED, __HIP_MEMORY_SCOPE_AGENT); }
__device__ __forceinline__ unsigned xb_add(unsigned* p, unsigned v) { return __hip_atomic_fetch_add(p, v, __ATOMIC_RELAXED, __HIP_MEMORY_SCOPE_AGENT); }
__device__ __forceinline__ unsigned xb_xcc_id() { return (unsigned)__builtin_amdgcn_s_getreg((3 << 11) | 20) & 0xFu; }
#define XB_SPIN(cond, bar) do { unsigned _sp = 0; while (cond) { __builtin_amdgcn_s_sleep(1); \
    if ((++_sp & 255u) == 0u) { if (xb_ld(&(bar)[XB_TMO])) break; if (_sp > XB_SPIN_CAP) { atomicAdd(&(bar)[XB_TMO], 1u); break; } } } } while (0)
struct XcdBarrier { unsigned* bar; unsigned x; volatile LAS unsigned* st; };
__device__ __forceinline__ XcdBarrier xcd_barrier_post(unsigned* bar, volatile LAS unsigned* st) {
    XcdBarrier b; b.bar = bar; b.x = xb_xcc_id(); b.st = st;
    if (threadIdx.x == 0) (void)xb_add(&bar[XB_XCNT(b.x)], 1u);
    return b;
}
__device__ __forceinline__ void xcd_barrier_complete(unsigned* bar, unsigned x, unsigned& nloc, unsigned& nx) {
    const unsigned G = gridDim.x * gridDim.y * gridDim.z;
    unsigned sum, cnt, mine, sp = 0u;
    for (;;) {
        sum = 0u; cnt = 0u; mine = 0u;
#pragma unroll
        for (unsigned j = 0; j < 16; ++j) { const unsigned c = xb_ld(&bar[XB_XCNT(j)]); sum += c; cnt += (c > 0u) ? 1u : 0u; mine = (j == x) ? c : mine; }
        if (sum == G) break;
        __builtin_amdgcn_s_sleep(1);
        if ((++sp & 255u) == 0u) { if (xb_ld(&bar[XB_TMO])) break; if (sp > XB_SPIN_CAP) { atomicAdd(&bar[XB_TMO], 1u); break; } }
    }
    nloc = mine > 0u ? mine : 1u; nx = cnt > 0u ? cnt : 1u;
}
__device__ __forceinline__ void xcd_barrier(const XcdBarrier& b) {
    asm volatile("s_waitcnt vmcnt(0)" ::: "memory");
    __syncthreads();
    if (threadIdx.x == 0) {
        unsigned* bar = b.bar;
        __builtin_amdgcn_s_waitcnt(0);
        unsigned nloc = b.st[0], nx = b.st[1];
        if (nloc == 0u) { xcd_barrier_complete(bar, b.x, nloc, nx); b.st[0] = nloc; b.st[1] = nx; }
        const unsigned old = xb_add(&bar[XB_XSUB(b.x)], 1u);
        const unsigned gen = old / nloc;
        if (old + 1u == (gen + 1u) * nloc) {
            __builtin_amdgcn_fence(__ATOMIC_RELEASE, "agent");
            asm volatile("s_waitcnt vmcnt(0)" ::: "memory");
            const unsigned og = xb_add(&bar[XB_TOP], 1u);
            const unsigned tg = og / nx;
            if (og + 1u == (tg + 1u) * nx) xb_add(&bar[XB_TOPGEN], 1u);
            else XB_SPIN(xb_ld(&bar[XB_TOPGEN]) == tg, bar);
            __builtin_amdgcn_fence(__ATOMIC_ACQUIRE, "agent");
            xb_add(&bar[XB_XGEN(b.x)], 1u);
            asm volatile("s_waitcnt vmcnt(0)" ::: "memory");
        } else {
            XB_SPIN(xb_ld(&bar[XB_XGEN(b.x)]) == gen, bar);
            __builtin_amdgcn_fence(__ATOMIC_ACQUIRE, "agent");
            asm volatile("s_waitcnt vmcnt(0)" ::: "memory");
        }
    }
    __syncthreads();
}

struct Args { const float* in[31]; float* out; unsigned char* ws; int lo, hi; int plan[48]; };
#define INP(i) ((const float*)(const GAS float*)a.in[({ int _i = (i); asm volatile("" : "+s"(_i)); _i; })])
struct Frame { LAS unsigned char* lds; int tid, lane, wave, vcu, G, gw, NGW; };
__device__ __forceinline__ Frame make_frame(LAS unsigned char* lds, int wave0) {
    Frame F; int ln; asm volatile("v_mbcnt_lo_u32_b32 %0, -1, 0\n\tv_mbcnt_hi_u32_b32 %0, -1, %0" : "=v"(ln)); int bx = blockIdx.x;        asm volatile("" : "+s"(bx));
    const int t = wave0 * 64 + ln;
    F.lds = lds; F.tid = t; F.lane = ln; F.wave = wave0;
    F.G = gridDim.x; F.vcu = (F.G % 8 == 0) ? (bx % 8) * (F.G / 8) + bx / 8 : bx;
    F.gw = F.vcu * 8 + F.wave; F.NGW = F.G * 8; return F;
}

__device__ __forceinline__ void tr_load(f32x4 (&v)[16], const float* W, int N, int item, int lane) {
    const int nblk = N / 64, kb = item / nblk, nb = item % nblk, k0 = 64 * kb, n0 = 64 * nb;
    const int lr = lane >> 4, lc = (lane & 15) * 4;
#pragma unroll
    for (int i = 0; i < 16; ++i) v[i] = __builtin_nontemporal_load((const f32x4*)(W + (size_t)(k0 + 4 * i + lr) * N + n0 + lc));
}
__device__ __forceinline__ void tr_to_lds(const f32x4 (&v)[16], LAS float* scr, int lane) {
    const int lr = lane >> 4, lc = (lane & 15) * 4;
#pragma unroll
    for (int i = 0; i < 16; ++i) { LAS float* d = scr + (4 * i + lr) * 65 + lc; d[0] = v[i].x; d[1] = v[i].y; d[2] = v[i].z; d[3] = v[i].w; }
}
template <class RowMap>
__device__ __forceinline__ void tr_emit(int K, int N, bf16_t* WT, const RowMap& rm, LAS float* scr, int item, int lane, const float* gk) {
    const int nblk = N / 64, kb = item / nblk, nb = item % nblk, k0 = 64 * kb, n0 = 64 * nb;
    LDS_WAIT(); asm volatile("" ::: "memory");
    const int c = lane & 7;
    f32x4 ga = {1.f, 1.f, 1.f, 1.f}, gb = {1.f, 1.f, 1.f, 1.f};
    if (gk) { ga = *(const f32x4*)(gk + k0 + 8 * c); gb = *(const f32x4*)(gk + k0 + 8 * c + 4); }
#pragma unroll
    for (int j = 0; j < 8; ++j) { const int n = (lane >> 3) + 8 * j; const LAS float* s = scr + (8 * c) * 65 + n;
        u32x4 o; o.x = cvt_pk_bf16(s[0 * 65] * ga.x, s[1 * 65] * ga.y); o.y = cvt_pk_bf16(s[2 * 65] * ga.z, s[3 * 65] * ga.w); o.z = cvt_pk_bf16(s[4 * 65] * gb.x, s[5 * 65] * gb.y); o.w = cvt_pk_bf16(s[6 * 65] * gb.z, s[7 * 65] * gb.w);
        *(u32x4*)(WT + (size_t)rm(n0 + n) * K + k0 + 8 * c) = o; }
    LDS_WAIT(); asm volatile("" ::: "memory");
}
struct RmId { int off; __device__ __forceinline__ int operator()(int n) const { return off + n; } };
struct RmAny { int mode, off; __device__ __forceinline__ int operator()(int n) const { return mode ? (n >> 7) * 256 + off + (n & 127) : off + n; } };
struct RmGU { int up; __device__ __forceinline__ int operator()(int n) const { return (n >> 7) * 256 + up * 128 + (n & 127); } };
__device__ __forceinline__ f32x4 bf4(u32x2 w) { return (f32x4){bflo(w.x), bfhi(w.x), bflo(w.y), bfhi(w.y)}; }
__device__ __forceinline__ u32x2 pk4(f32x4 v) { u32x2 w; w.x = cvt_pk_bf16(v.x, v.y); w.y = cvt_pk_bf16(v.z, v.w); return w; }
__device__ __forceinline__ void stat_pass(const Frame& F, bf16_t* xb, float* R, const bf16_t* P, float fix, const float* src0, const float* src1, const float* SSP) {
    if (!src0) {
        for (int row = F.vcu * NTHR + F.tid; row < MP; row += F.G * NTHR) { const f32x4* sp = (const f32x4*)(SSP + (size_t)row * 32); f32x4 t = sp[0];
#pragma unroll
            for (int k = 1; k < 8; ++k) t += sp[k];
            R[row] = rsq(((t.x + t.y) + (t.z + t.w)) * (1.f / DM) + EPS); }
    }
    else for (int row = F.gw; row < MP; row += 2 * F.NGW) {
        const int row2 = row + F.NGW; const bool two = row2 < MP;
        f32x4 v[2][8];
#pragma unroll
        for (int q = 0; q < 2; ++q) { const int r = q ? row2 : row; if (q == 0 || two) {
            if (src0) { const f32x4* sr = (const f32x4*)(src0 + (size_t)r * DM) + F.lane;
#pragma unroll
                for (int j = 0; j < 8; ++j) v[q][j] = sr[64 * j]; }
            else { const u32x2* sr = (const u32x2*)(xb + (size_t)r * DM) + F.lane;
#pragma unroll
                for (int j = 0; j < 8; ++j) v[q][j] = bf4(sr[64 * j]); } } }
#pragma unroll
        for (int q = 0; q < 2; ++q) { const int r = q ? row2 : row; if (q == 0 || two) {
            float s = 0.f;
            if (src0) { u32x2* xr = (u32x2*)(xb + (size_t)r * DM) + F.lane;
#pragma unroll
                for (int j = 0; j < 8; ++j) { const u32x2 w = pk4(v[q][j]); xr[64 * j] = w; v[q][j] = bf4(w); } }
#pragma unroll
            for (int j = 0; j < 8; ++j) s += (v[q][j].x * v[q][j].x + v[q][j].y * v[q][j].y) + (v[q][j].z * v[q][j].z + v[q][j].w * v[q][j].w);
            const float rr = rsq(wave_sum(s) * (1.f / DM) + EPS);
            if (F.lane == 0) R[r] = rr; } }
    }
    for (int row = MP + F.gw; row < M; row += F.NGW) {
        u32x2* xr = (u32x2*)(xb + (size_t)row * DM) + F.lane;
        f32x4 v[8]; float s = 0.f;
        if (src0) { const f32x4* sr = (const f32x4*)(src1 + (size_t)(row - MP) * DM) + F.lane;
#pragma unroll
            for (int j = 0; j < 8; ++j) v[j] = sr[64 * j]; }
        else {
#pragma unroll
            for (int j = 0; j < 8; ++j) v[j] = bf4(xr[64 * j]); }
        if (fix != 0.f) {
            const u32x2* pr = (const u32x2*)(P + (size_t)(row - MP) * DM) + F.lane;
#pragma unroll
            for (int j = 0; j < 8; ++j) { f32x4 t = {0.f, 0.f, 0.f, 0.f};
#pragma unroll
                for (int sl = 0; sl < 8; ++sl) t += bf4(pr[(size_t)sl * (1024 * 2048 / 4) + 64 * j]);
                v[j] += t * fix; }
        }
        if (src0 || fix != 0.f) {
#pragma unroll
            for (int j = 0; j < 8; ++j) { const u32x2 w = pk4(v[j]); xr[64 * j] = w; v[j] = bf4(w); }
        }
#pragma unroll
        for (int j = 0; j < 8; ++j) s += (v[j].x * v[j].x + v[j].y * v[j].y) + (v[j].z * v[j].z + v[j].w * v[j].w);
        const float rr = rsq(wave_sum(s) * (1.f / DM) + EPS);
        if (F.lane == 0) R[row] = rr;
    }
}

__device__ __forceinline__ void stat_pass2(const Frame& F, bf16_t* xb, float* R, const bf16_t* P, float fix, const float* SSP) {
    if (F.tid < 256) { const int row = 32 * F.vcu + (F.tid >> 3); const f32x4 t = *(const f32x4*)(SSP + (size_t)row * 32 + 4 * (F.tid & 7));
        float s = (t.x + t.y) + (t.z + t.w); s += dpp_f<0xB1>(s); s += dpp_f<0x4E>(s); s += dpp_f<0x141>(s);
        if ((F.tid & 7) == 0) R[row] = rsq(s * (1.f / DM) + EPS); }
    const int half = F.wave >> 2, row = MP + 4 * F.vcu + (F.wave & 3);
    u32x4* xr = (u32x4*)(xb + (size_t)row * DM + half * 1024) + F.lane;
    const u32x4* pr = (const u32x4*)(P + (size_t)(row - MP) * DM + half * 1024) + F.lane;
    u32x4 w[2], q[8][2];
#pragma unroll
    for (int j = 0; j < 2; ++j) w[j] = xr[64 * j];
#pragma unroll
    for (int sl = 0; sl < 8; ++sl)
#pragma unroll
        for (int j = 0; j < 2; ++j) q[sl][j] = pr[(size_t)sl * (1024 * 2048 / 8) + 64 * j];
    float s = 0.f;
#pragma unroll
    for (int j = 0; j < 2; ++j) {
        f32x4 t0 = {0.f, 0.f, 0.f, 0.f}, t1 = {0.f, 0.f, 0.f, 0.f};
#pragma unroll
        for (int sl = 0; sl < 8; ++sl) { t0 += bf4((u32x2){q[sl][j].x, q[sl][j].y}); t1 += bf4((u32x2){q[sl][j].z, q[sl][j].w}); }
        const f32x4 v0 = bf4((u32x2){w[j].x, w[j].y}) + t0 * fix, v1 = bf4((u32x2){w[j].z, w[j].w}) + t1 * fix;
        const u32x2 o0 = pk4(v0), o1 = pk4(v1);
        xr[64 * j] = (u32x4){o0.x, o0.y, o1.x, o1.y};
        const f32x4 r0 = bf4(o0), r1 = bf4(o1);
        s += (r0.x * r0.x + r0.y * r0.y) + (r0.z * r0.z + r0.w * r0.w) + (r1.x * r1.x + r1.y * r1.y) + (r1.z * r1.z + r1.w * r1.w);
    }
    s = wave_sum(s);
    LAS float* sc = (LAS float*)(F.lds + AUX_OFF + 6144);
    if (F.lane == 0) sc[F.wave] = s;
    __syncthreads();
    if (F.wave < 4 && F.lane == 0) R[row] = rsq((sc[F.wave] + sc[F.wave + 4]) * (1.f / DM) + EPS);
}

template <int W> __device__ __forceinline__ void pool16(const float* zc, const float* hs, bf16_t* pc, int l0, bool prm) {
    float u[W + 15];
#pragma unroll
    for (int t = 0; t < W + 15; ++t) { const int l = l0 - (W - 1) + t; u[t] = l >= 0 ? zc[(size_t)l * EVINP] : (prm ? 0.f : hs[(size_t)(15 + l) * POOLD]); }
    float sum = 0.f;
#pragma unroll
    for (int t = 0; t < W - 1; ++t) sum += u[t];
#pragma unroll
    for (int i = 0; i < 16; ++i) { const float ul = u[W - 1 + i]; sum += ul; const int l = l0 + i;
        const float cnt = prm ? (float)(l + 1 < W ? l + 1 : W) : (float)W;
        pc[(size_t)l * POOLD] = f2bf(sum / cnt - ul); sum -= u[i]; }
}

__device__ __forceinline__ int crow(int r, int hi) { return (r & 3) + 8 * (r >> 2) + 4 * hi; }
__device__ __forceinline__ int v_st(int k, int c) { const int kk = (k & ~0xC) | ((k & 4) << 1) | ((k & 8) >> 1); return ((kk >> 3) * 4 + (c >> 5)) * 512 + ((kk & 7) * 32 + (c & 31)) * 2; }
__device__ __forceinline__ int v_rd_base(int lane) { return ((lane & 3) << 3) | (((lane >> 2) & 3) << 6) | (((lane >> 4) & 1) << 5) | (((lane >> 5) & 1) << 8); }
constexpr int v_rd_off(int d0, int ks, int half) { return d0 * 512 + ks * 4096 + half * 2048; }
template <int OFF> __device__ __forceinline__ s16x4 tr_read(int vb) {
    s16x4 r; asm volatile("ds_read_b64_tr_b16 %0, %1 offset:%2" : "=&v"(r) : "v"(vb), "i"(OFF) : "memory"); return r;
}
template <int D0> __device__ __forceinline__ void pv_one32(f32x16& od, int vb, bf16x8 pa0, bf16x8 pa1) {
    const s16x4 l0 = tr_read<v_rd_off(D0, 0, 0)>(vb), h0 = tr_read<v_rd_off(D0, 0, 1)>(vb), l1 = tr_read<v_rd_off(D0, 1, 0)>(vb), h1 = tr_read<v_rd_off(D0, 1, 1)>(vb);
    asm volatile("s_waitcnt lgkmcnt(0)" ::: "memory"); SBAR();
#define PK(L, H) (bf16x8){L[0], L[1], L[2], L[3], H[0], H[1], H[2], H[3]}
    od = __builtin_amdgcn_mfma_f32_32x32x16_bf16(pa0, PK(l0, h0), od, 0, 0, 0);
    od = __builtin_amdgcn_mfma_f32_32x32x16_bf16(pa1, PK(l1, h1), od, 0, 0, 0);
#undef PK
}
__device__ __forceinline__ void pv32(f32x16* o, int vb, bf16x8 pa0, bf16x8 pa1) {
    const s16x4 a0 = tr_read<v_rd_off(0, 0, 0)>(vb), a1 = tr_read<v_rd_off(0, 0, 1)>(vb), a2 = tr_read<v_rd_off(0, 1, 0)>(vb), a3 = tr_read<v_rd_off(0, 1, 1)>(vb);
    const s16x4 b0 = tr_read<v_rd_off(1, 0, 0)>(vb), b1 = tr_read<v_rd_off(1, 0, 1)>(vb), b2 = tr_read<v_rd_off(1, 1, 0)>(vb), b3 = tr_read<v_rd_off(1, 1, 1)>(vb);
    const s16x4 c0 = tr_read<v_rd_off(2, 0, 0)>(vb), c1 = tr_read<v_rd_off(2, 0, 1)>(vb), c2 = tr_read<v_rd_off(2, 1, 0)>(vb), c3 = tr_read<v_rd_off(2, 1, 1)>(vb);
    const s16x4 d0 = tr_read<v_rd_off(3, 0, 0)>(vb), d1 = tr_read<v_rd_off(3, 0, 1)>(vb), d2 = tr_read<v_rd_off(3, 1, 0)>(vb), d3 = tr_read<v_rd_off(3, 1, 1)>(vb);
    asm volatile("s_waitcnt lgkmcnt(0)" ::: "memory"); SBAR();
#define PK(L, H) (bf16x8){L[0], L[1], L[2], L[3], H[0], H[1], H[2], H[3]}
    o[0] = __builtin_amdgcn_mfma_f32_32x32x16_bf16(pa0, PK(a0, a1), o[0], 0, 0, 0); o[1] = __builtin_amdgcn_mfma_f32_32x32x16_bf16(pa0, PK(b0, b1), o[1], 0, 0, 0);
    o[2] = __builtin_amdgcn_mfma_f32_32x32x16_bf16(pa0, PK(c0, c1), o[2], 0, 0, 0); o[3] = __builtin_amdgcn_mfma_f32_32x32x16_bf16(pa0, PK(d0, d1), o[3], 0, 0, 0);
    o[0] = __builtin_amdgcn_mfma_f32_32x32x16_bf16(pa1, PK(a2, a3), o[0], 0, 0, 0); o[1] = __builtin_amdgcn_mfma_f32_32x32x16_bf16(pa1, PK(b2, b3), o[1], 0, 0, 0);
    o[2] = __builtin_amdgcn_mfma_f32_32x32x16_bf16(pa1, PK(c2, c3), o[2], 0, 0, 0); o[3] = __builtin_amdgcn_mfma_f32_32x32x16_bf16(pa1, PK(d2, d3), o[3], 0, 0, 0);
#undef PK
}
struct VFrags { s16x4 f[16]; };
__device__ __forceinline__ void pv_load(VFrags& V, int vb) {
    V.f[0] = tr_read<v_rd_off(0, 0, 0)>(vb); V.f[1] = tr_read<v_rd_off(0, 0, 1)>(vb); V.f[2] = tr_read<v_rd_off(0, 1, 0)>(vb); V.f[3] = tr_read<v_rd_off(0, 1, 1)>(vb);
    V.f[4] = tr_read<v_rd_off(1, 0, 0)>(vb); V.f[5] = tr_read<v_rd_off(1, 0, 1)>(vb); V.f[6] = tr_read<v_rd_off(1, 1, 0)>(vb); V.f[7] = tr_read<v_rd_off(1, 1, 1)>(vb);
    V.f[8] = tr_read<v_rd_off(2, 0, 0)>(vb); V.f[9] = tr_read<v_rd_off(2, 0, 1)>(vb); V.f[10] = tr_read<v_rd_off(2, 1, 0)>(vb); V.f[11] = tr_read<v_rd_off(2, 1, 1)>(vb);
    V.f[12] = tr_read<v_rd_off(3, 0, 0)>(vb); V.f[13] = tr_read<v_rd_off(3, 0, 1)>(vb); V.f[14] = tr_read<v_rd_off(3, 1, 0)>(vb); V.f[15] = tr_read<v_rd_off(3, 1, 1)>(vb);
}
__device__ __forceinline__ void pv_mma(f32x16* o, const VFrags& V, bf16x8 pa0, bf16x8 pa1) {
#define PK(L, H) (bf16x8){L[0], L[1], L[2], L[3], H[0], H[1], H[2], H[3]}
#pragma unroll
    for (int d = 0; d < 4; ++d) o[d] = __builtin_amdgcn_mfma_f32_32x32x16_bf16(pa0, PK(V.f[4 * d], V.f[4 * d + 1]), o[d], 0, 0, 0);
#pragma unroll
    for (int d = 0; d < 4; ++d) o[d] = __builtin_amdgcn_mfma_f32_32x32x16_bf16(pa1, PK(V.f[4 * d + 2], V.f[4 * d + 3]), o[d], 0, 0, 0);
#undef PK
}
#define VT_LOAD(vr, src, ld) do { _Pragma("unroll") for (int _it = 0; _it < 8; ++_it) vr[_it] = *(const bf16x8*)((src) + (size_t)(4 * _it + (lane >> 4)) * (ld) + (lane & 15) * 8); } while (0)
#define VT_WRITE(vl, vr) do { _Pragma("unroll") for (int _it = 0; _it < 8; ++_it) *(LAS bf16x8*)((vl) + v_st(4 * _it + (lane >> 4), (lane & 15) * 8)) = vr[_it]; } while (0)

__device__ __forceinline__ void load_q_frags(bf16x8 (&qr)[12], const bf16_t* Q, int row, int h, int hi, const float* tab, const float* gqn, const float* gqp) {
    const bf16_t* qp = Q + (size_t)row * 1536 + h * QKH + 8 * hi;
        bf16x8 raw[12];
#pragma unroll
        for (int d0 = 0; d0 < 12; ++d0) raw[d0] = *(const bf16x8*)(qp + 16 * d0);
        float ssn = 0.f, ssp = 0.f;
#pragma unroll
        for (int d0 = 0; d0 < 12; ++d0)
#pragma unroll
            for (int j = 0; j < 8; ++j) { const float f = bf1(raw[d0][j]); if (d0 < 8) ssn += f * f; else ssp += f * f; }
        ssn = xor32_sum(ssn); ssp = xor32_sum(ssp);
        const float rn = rsq(ssn * (1.f / NOPE) + EPS), rp = rsq(ssp * (1.f / ROPE) + EPS);
#pragma unroll
        for (int d0 = 0; d0 < 8; ++d0) { float v[8]; const float* gp = gqn + 16 * d0 + 8 * hi;
#pragma unroll
            for (int j = 0; j < 8; ++j) v[j] = bf1(raw[d0][j]) * rn * gp[j];
            qr[d0] = pack8(v); }
#pragma unroll
        for (int d0 = 8; d0 < 10; ++d0) { float v1[8], v2[8]; const int i0 = 16 * (d0 - 8) + 8 * hi; const float* tp = tab + (size_t)row * 64 + i0;
#pragma unroll
            for (int j = 0; j < 8; ++j) { const float x1 = bf1(raw[d0][j]) * rp * gqp[i0 + j], x2 = bf1(raw[d0 + 2][j]) * rp * gqp[i0 + 32 + j]; const float c = tp[j], s = tp[32 + j];
                v1[j] = x1 * c - x2 * s; v2[j] = x1 * s + x2 * c; }
            qr[d0] = pack8(v1); qr[d0 + 2] = pack8(v2); }
}

struct AttnUnit { int qrow0, h, ntiles; const bf16_t* kv; const bf16_t* kpe; };
__device__ __forceinline__ void attn_unit(const Frame& F, const AttnUnit& U, const bf16_t* Q, const float* tab, const float* gqn, const float* gqp, bf16_t* mix) {
    int lane_; asm volatile("v_mbcnt_lo_u32_b32 %0, -1, 0\n\tv_mbcnt_hi_u32_b32 %0, -1, %0" : "=v"(lane_));
    const int lane = lane_, wid = F.wave, r32 = lane & 31, hi = lane >> 5;
    LAS unsigned char* lds = F.lds;
    constexpr int QF_OFF = 102400, KVT = 12800;
    {
        bf16x8 qr[12];
        load_q_frags(qr, Q, U.qrow0 + r32, U.h, hi, tab, gqn, gqp);
        if (wid == 0) {
#pragma unroll
            for (int d0 = 0; d0 < 12; ++d0) *(LAS bf16x8*)(lds + QF_OFF + d0 * 1024 + lane * 16) = qr[d0]; }
    }
    __syncthreads();
    f32x16 o[4];
#pragma unroll
    for (int d = 0; d < 4; ++d)
#pragma unroll
        for (int r = 0; r < 16; ++r) o[d][r] = 0.f;
    float m_reg = -1e30f, l_reg = 0.f;
    LAS unsigned char* vl = lds + wid * KVT;
    LAS float* aux = (LAS float*)(lds + AUX_OFF);
    LAS float* al_l = aux + 768 + wid * 32;
    const int vb = (int)(uintptr_t)vl + v_rd_base(lane);
    const bf16_t* kvh = U.kv + U.h * 256;
    bf16x8 kf[12], vr[8];
#define KLOAD(t_) do { const bf16_t* kp_ = kvh + (size_t)(32 * (t_) + (lane >> 4)) * 2048 + 8 * (lane & 15); const bf16_t* pp_ = U.kpe + (size_t)(32 * (t_) + (lane >> 3)) * 64 + 8 * (lane & 7); \
        _Pragma("unroll") for (int i_ = 0; i_ < 8; ++i_) kf[i_] = *(const bf16x8*)(kp_ + (size_t)(4 * i_) * 2048);        \
        _Pragma("unroll") for (int i_ = 0; i_ < 4; ++i_) kf[8 + i_] = *(const bf16x8*)(pp_ + (size_t)(8 * i_) * 64); } while (0)
#define KWRITE() do { _Pragma("unroll") for (int i_ = 0; i_ < 8; ++i_) *(LAS bf16x8*)(vl + (4 * i_ + (lane >> 4)) * 400 + 16 * (lane & 15)) = kf[i_]; \
        _Pragma("unroll") for (int i_ = 0; i_ < 4; ++i_) *(LAS bf16x8*)(vl + (8 * i_ + (lane >> 3)) * 400 + 256 + 16 * (lane & 7)) = kf[8 + i_]; } while (0)
    int t = wid;
    if (t < U.ntiles) { KLOAD(t); VT_LOAD(vr, kvh + (size_t)(32 * t) * 2048 + 128, 2048); }
    for (; t < U.ntiles; t += 8) {
        const int tn = t + 8;
        KWRITE();
        bf16x8 kq[12];
#pragma unroll
        for (int d0 = 0; d0 < 12; ++d0) kq[d0] = *(const LAS bf16x8*)(vl + r32 * 400 + 32 * d0 + 16 * hi);
        f32x16 p;
#pragma unroll
        for (int r = 0; r < 16; ++r) p[r] = 0.f;
#pragma unroll
        for (int d0 = 0; d0 < 12; ++d0) { const bf16x8 qf = *(const LAS bf16x8*)(lds + QF_OFF + d0 * 1024 + lane * 16); p = __builtin_amdgcn_mfma_f32_32x32x16_bf16(kq[d0], qf, p, 0, 0, 0); }
        if (tn < U.ntiles) KLOAD(tn);
        VT_WRITE(vl, vr);
        if (tn < U.ntiles) VT_LOAD(vr, kvh + (size_t)(32 * tn) * 2048 + 128, 2048);
        float pmax = p[0];
#pragma unroll
        for (int r = 1; r < 16; ++r) pmax = fmaxf(pmax, p[r]);
        pmax = xor32_max(pmax);
        const float mn = fmaxf(m_reg, pmax);
        const float alpha = __builtin_amdgcn_exp2f((m_reg - mn) * ATTN_C);
        m_reg = mn;
        const float mnC = mn * ATTN_C;
        float ps = 0.f;
#pragma unroll
        for (int r = 0; r < 16; ++r) { p[r] = __builtin_amdgcn_exp2f(fmaf(p[r], ATTN_C, -mnC)); ps += p[r]; }
        ps = xor32_sum(ps);
        l_reg = l_reg * alpha + ps;
        if (__any(alpha < 1.f)) {
            if (hi == 0) al_l[r32] = alpha;
            LDS_WAIT();
#pragma unroll
            for (int r = 0; r < 16; ++r) { const float a = al_l[crow(r, hi)];
#pragma unroll
                for (int d = 0; d < 4; ++d) o[d][r] *= a; }
        }
        bf16x8 pa0, pa1;
#define PK4(P, BASE, OUT) do { unsigned a0 = cvt_pk_bf16(P[BASE + 0], P[BASE + 1]), a1 = cvt_pk_bf16(P[BASE + 2], P[BASE + 3]);   \
    unsigned b0 = cvt_pk_bf16(P[BASE + 4], P[BASE + 5]), b1 = cvt_pk_bf16(P[BASE + 6], P[BASE + 7]);                              \
    auto r0 = __builtin_amdgcn_permlane32_swap(a0, b0, false, false); auto r1 = __builtin_amdgcn_permlane32_swap(a1, b1, false, false); \
    u32x4 w = {r0[0], r1[0], r0[1], r1[1]}; OUT = __builtin_bit_cast(bf16x8, w); } while (0)
        PK4(p, 0, pa0); PK4(p, 8, pa1);
#undef PK4
        pv32(o, vb, pa0, pa1);
    }
#undef KLOAD
#undef KWRITE
    if (hi == 0) { aux[wid * 32 + r32] = m_reg; aux[256 + wid * 32 + r32] = l_reg; }
    __syncthreads();
    float Mx = -1e30f;
#pragma unroll
    for (int w = 0; w < 8; ++w) Mx = fmaxf(Mx, aux[w * 32 + r32]);
    float L = 0.f;
#pragma unroll
    for (int w = 0; w < 8; ++w) L += aux[256 + w * 32 + r32] * __builtin_amdgcn_exp2f((aux[w * 32 + r32] - Mx) * ATTN_C);
    const float sc = __builtin_amdgcn_exp2f((m_reg - Mx) * ATTN_C) / L;
    if (hi == 0) aux[512 + wid * 32 + r32] = sc;
    LDS_WAIT();
    LAS float* ob = (LAS float*)lds + wid * 4096;
#pragma unroll
    for (int r = 0; r < 16; ++r) { const int row = crow(r, hi); const float a = aux[512 + wid * 32 + row];
#pragma unroll
        for (int d = 0; d < 4; ++d) ob[row * 128 + 32 * d + r32] = o[d][r] * a; }
    __syncthreads();
    {
        const int tid = wid * 64 + lane, row = tid >> 4, c8 = (tid & 15) * 8;
        f32x4 s0 = {0.f, 0.f, 0.f, 0.f}, s1 = {0.f, 0.f, 0.f, 0.f};
#pragma unroll
        for (int w = 0; w < 8; ++w) { const LAS f32x4* pw = (const LAS f32x4*)((LAS float*)lds + w * 4096 + row * 128 + c8); s0 += pw[0]; s1 += pw[1]; }
        float v[8] = {s0.x, s0.y, s0.z, s0.w, s1.x, s1.y, s1.z, s1.w};
        *(bf16x8*)(mix + (size_t)(U.qrow0 + row) * 2048 + 1024 + U.h * 128 + c8) = pack8(v);
    }
    __syncthreads();
}

constexpr int AT_VPM = 12;
constexpr int AT_KP = 400, AT_K = 0, AT_V = 64 * AT_KP, AT_BUF = AT_V + 16384;
__device__ __forceinline__ void attn_unit128(const Frame& F, int h, int qb4, const bf16_t* Q, const bf16_t* kv, const bf16_t* kpe, const float* tab, const float* gqn, const float* gqp, bf16_t* mix) {
    int lane_; asm volatile("v_mbcnt_lo_u32_b32 %0, -1, 0\n\tv_mbcnt_hi_u32_b32 %0, -1, %0" : "=v"(lane_));
    const int lane = lane_, wid = F.wave, r32 = lane & 31, hi = lane >> 5, qs = wid & 3, kg = wid >> 2, tid = wid * 64 + lane;
    LAS unsigned char* lds = F.lds;
    const int q0 = 128 * qb4, nst = 2 * qb4 + 2, mylast = 2 * qb4 + (qs >> 1);
    bf16x8 qr[12];
    load_q_frags(qr, Q, q0 + 32 * qs + r32, h, hi, tab, gqn, gqp);
    f32x16 o[4];
#pragma unroll
    for (int d = 0; d < 4; ++d)
#pragma unroll
        for (int r = 0; r < 16; ++r) o[d][r] = 0.f;
    float m_reg = -1e30f, l_reg = 0.f;
    LAS float* aux = (LAS float*)(lds + AUX_OFF);
    LAS float* al_l = aux + 768 + wid * 32;
    const bf16_t* kvh = kv + h * 256;
    const int vrow = tid >> 4, vcc = tid & 15;
    const int prow = tid >> 3, pcc = tid & 7;
    const unsigned vdst = (unsigned)(AT_V + v_st(vrow, 8 * vcc)), kdst = (unsigned)(AT_K + vrow * AT_KP + 16 * vcc), pdst = (unsigned)(AT_K + prow * AT_KP + 256 + 16 * pcc);
    bf16x8 sr[5];
#define AT_LOAD(j_) do { const bf16_t* b_ = kvh + (size_t)(64 * (j_)) * 2048; \
        sr[0] = *(const bf16x8*)(b_ + (size_t)vrow * 2048 + 128 + 8 * vcc); sr[1] = *(const bf16x8*)(b_ + (size_t)(vrow + 32) * 2048 + 128 + 8 * vcc); \
        sr[2] = *(const bf16x8*)(b_ + (size_t)vrow * 2048 + 8 * vcc); sr[3] = *(const bf16x8*)(b_ + (size_t)(vrow + 32) * 2048 + 8 * vcc); \
        sr[4] = *(const bf16x8*)(kpe + (size_t)(64 * (j_) + prow) * 64 + 8 * pcc); } while (0)
#define AT_WRITE(b_) do { LAS unsigned char* s_ = lds + (b_) * AT_BUF; \
        *(LAS bf16x8*)(s_ + vdst) = sr[0]; *(LAS bf16x8*)(s_ + vdst + 8192) = sr[1]; \
        *(LAS bf16x8*)(s_ + kdst) = sr[2]; *(LAS bf16x8*)(s_ + kdst + 32 * AT_KP) = sr[3]; *(LAS bf16x8*)(s_ + pdst) = sr[4]; } while (0)
    AT_LOAD(0); AT_WRITE(0);
    __syncthreads();
    const int kro = AT_K + (32 * kg + r32) * AT_KP + 16 * hi;
    const int vbb = (int)(uintptr_t)lds + AT_V + kg * 8192 + v_rd_base(lane);
    VFrags VF;
#pragma unroll
    for (int i = 0; i < 16; ++i) VF.f[i] = (s16x4){0, 0, 0, 0};
    bf16x8 pa0 = {0, 0, 0, 0, 0, 0, 0, 0}, pa1 = {0, 0, 0, 0, 0, 0, 0, 0};
    for (int j = 0; j < nst; ++j) {
        const int b = j & 1;
        if (j + 1 < nst) AT_LOAD(j + 1);
        if (j <= mylast) {
            const LAS unsigned char* ks = lds + b * AT_BUF + kro;
            f32x16 p;
#pragma unroll
            for (int r = 0; r < 16; ++r) p[r] = 0.f;
            { bf16x8 ka[4], kb[4];
#pragma unroll
              for (int d0 = 0; d0 < 4; ++d0) ka[d0] = *(const LAS bf16x8*)(ks + 32 * d0);
#pragma unroll
              for (int d0 = 0; d0 < 4; ++d0) kb[d0] = *(const LAS bf16x8*)(ks + 32 * (4 + d0));
              SBAR();
#pragma unroll
              for (int d0 = 0; d0 < 4; ++d0) p = __builtin_amdgcn_mfma_f32_32x32x16_bf16(ka[d0], qr[d0], p, 0, 0, 0);
              SBAR();
#pragma unroll
              for (int d0 = 0; d0 < 4; ++d0) ka[d0] = *(const LAS bf16x8*)(ks + 32 * (8 + d0));
              SBAR();
#pragma unroll
              for (int d0 = 0; d0 < 4; ++d0) p = __builtin_amdgcn_mfma_f32_32x32x16_bf16(kb[d0], qr[4 + d0], p, 0, 0, 0);
              SBAR();
#pragma unroll
              for (int d0 = 0; d0 < 4; ++d0) p = __builtin_amdgcn_mfma_f32_32x32x16_bf16(ka[d0], qr[8 + d0], p, 0, 0, 0); }
            asm volatile("s_waitcnt lgkmcnt(0)" ::: "memory"); SBAR();
            pv_mma(o, VF, pa0, pa1);
            float pmax = p[0];
#pragma unroll
            for (int r = 1; r < 16; ++r) pmax = fmaxf(pmax, p[r]);
            pmax = xor32_max(pmax);
            const float mn = fmaxf(m_reg, pmax);
            const float alpha = __builtin_amdgcn_exp2f((m_reg - mn) * ATTN_C);
            m_reg = mn;
            const float mnC = mn * ATTN_C;
            float ps = 0.f;
#pragma unroll
            for (int r = 0; r < 16; ++r) { p[r] = __builtin_amdgcn_exp2f(fmaf(p[r], ATTN_C, -mnC)); ps += p[r]; }
            ps = xor32_sum(ps);
            l_reg = l_reg * alpha + ps;
            bf16x8 na0, na1;
#define PK4(P, BASE, OUT) do { unsigned a0 = cvt_pk_bf16(P[BASE + 0], P[BASE + 1]), a1 = cvt_pk_bf16(P[BASE + 2], P[BASE + 3]);   \
    unsigned b0 = cvt_pk_bf16(P[BASE + 4], P[BASE + 5]), b1 = cvt_pk_bf16(P[BASE + 6], P[BASE + 7]);                              \
    auto r0 = __builtin_amdgcn_permlane32_swap(a0, b0, false, false); auto r1 = __builtin_amdgcn_permlane32_swap(a1, b1, false, false); \
    u32x4 w = {r0[0], r1[0], r0[1], r1[1]}; OUT = __builtin_bit_cast(bf16x8, w); } while (0)
            PK4(p, 0, na0); PK4(p, 8, na1);
#undef PK4
#pragma unroll
            for (int i = 0; i < 8; ++i) { __builtin_amdgcn_sched_group_barrier(0x008, 1, 0); __builtin_amdgcn_sched_group_barrier(0x002, AT_VPM, 0); }
            SBAR();
            pv_load(VF, vbb + b * AT_BUF);
            if (__any(alpha < 1.f)) {
                if (hi == 0) al_l[r32] = alpha;
                LDS_WAIT();
#pragma unroll
                for (int r = 0; r < 16; ++r) { const float a = al_l[crow(r, hi)];
#pragma unroll
                    for (int d = 0; d < 4; ++d) o[d][r] *= a; }
            }
            pa0 = na0; pa1 = na1;
        }
        if (j + 1 < nst) AT_WRITE(b ^ 1);
        __syncthreads();
    }
    asm volatile("s_waitcnt lgkmcnt(0)" ::: "memory"); SBAR();
    pv_mma(o, VF, pa0, pa1);
#undef AT_LOAD
#undef AT_WRITE
    if (hi == 0) { aux[wid * 32 + r32] = m_reg; aux[256 + wid * 32 + r32] = l_reg; }
    __syncthreads();
    const int pw = wid ^ 4;
    const float mo = aux[pw * 32 + r32], lo = aux[256 + pw * 32 + r32];
    const float Mx = fmaxf(m_reg, mo);
    const float es = __builtin_amdgcn_exp2f((m_reg - Mx) * ATTN_C), eo = __builtin_amdgcn_exp2f((mo - Mx) * ATTN_C);
    const float sc = es / (l_reg * es + lo * eo);
    if (hi == 0) aux[512 + wid * 32 + r32] = sc;
    LDS_WAIT();
    LAS float* ob = (LAS float*)lds + wid * 4096;
#pragma unroll
    for (int r = 0; r < 16; ++r) { const int row = crow(r, hi); const float a = aux[512 + wid * 32 + row];
#pragma unroll
        for (int d = 0; d < 4; ++d) ob[row * 128 + 32 * d + r32] = o[d][r] * a; }
    __syncthreads();
    {
        int l2 = lane; asm volatile("" : "+v"(l2)); const int te = wid * 64 + l2;
        const int row = te >> 2, seg = (te & 3) * 32, w0 = row >> 5, rr = row & 31;
        const LAS f32x4* pa = (const LAS f32x4*)((LAS float*)lds + w0 * 4096 + rr * 128 + seg);
        const LAS f32x4* pb = (const LAS f32x4*)((LAS float*)lds + (w0 + 4) * 4096 + rr * 128 + seg);
        bf16_t* dst = mix + (size_t)(q0 + row) * 2048 + 1024 + h * 128 + seg;
#pragma unroll
        for (int q = 0; q < 4; ++q) { const f32x4 x0 = pa[2 * q] + pb[2 * q], x1 = pa[2 * q + 1] + pb[2 * q + 1];
            float v[8] = {x0.x, x0.y, x0.z, x0.w, x1.x, x1.y, x1.z, x1.w}; *(bf16x8*)(dst + 8 * q) = pack8(v); }
    }
    __syncthreads();
}

__device__ __forceinline__ void gate_item(const Frame& F, int row0, int arow0, int jrow0, int ntj, int g, int c0, const bf16_t* wsg, const float* bsg, const float* SSV, const float* gv, const bf16_t* ZU, bf16_t* US, float* OVS) {
    const int lane = F.lane, r32 = lane & 31, hi = lane >> 5;
    LAS unsigned char* vl = F.lds + F.wave * 8192;
    const int vb = (int)(uintptr_t)vl + v_rd_base(lane);
    bf16x8 vr[8];
    VT_LOAD(vr, ZU + (size_t)jrow0 * 4096 + 2048 + c0, 4096);
    LAS float* rt = (LAS float*)(F.lds + 135168 + F.wave * 512);
    for (int rr = lane; rr < 32 * ntj; rr += 64) { const f32x4* sp = (const f32x4*)(SSV + (size_t)(jrow0 + rr) * 32); f32x4 t = sp[0];
#pragma unroll
        for (int k = 1; k < 8; ++k) t += sp[k];
        rt[rr] = rsq(((t.x + t.y) + (t.z + t.w)) * (1.f / GATE) + EPS); }
    const f32x4 gv0 = *(const f32x4*)(gv + c0 + (lane & 15) * 8), gv1 = *(const f32x4*)(gv + c0 + (lane & 15) * 8 + 4);
    f32x16 o[4];
#pragma unroll
    for (int d = 0; d < 4; ++d)
#pragma unroll
        for (int r = 0; r < 16; ++r) o[d][r] = 0.f;
    for (int jt = 0; jt < ntj; ++jt) {
#pragma unroll
        for (int it = 0; it < 8; ++it) { const float r = rt[32 * jt + 4 * it + (lane >> 4)]; const u32x4 w = __builtin_bit_cast(u32x4, vr[it]);
            float v[8] = {bflo(w.x), bfhi(w.x), bflo(w.y), bfhi(w.y), bflo(w.z), bfhi(w.z), bflo(w.w), bfhi(w.w)};
            v[0] *= r * gv0.x; v[1] *= r * gv0.y; v[2] *= r * gv0.z; v[3] *= r * gv0.w; v[4] *= r * gv1.x; v[5] *= r * gv1.y; v[6] *= r * gv1.z; v[7] *= r * gv1.w;
            vr[it] = pack8(v);
            if (OVS) { float* ov = OVS + (size_t)(32 * jt + 4 * it + (lane >> 4)) * GATE + c0 + (lane & 15) * 8;
                *(f32x4*)ov = (f32x4){v[0], v[1], v[2], v[3]}; *(f32x4*)(ov + 4) = (f32x4){v[4], v[5], v[6], v[7]}; } }
        const bf16_t* ap = wsg + (size_t)(arow0 + r32) * 128 + 32 * jt + 8 * hi;
        const bf16x8 pa0 = *(const bf16x8*)ap, pa1 = *(const bf16x8*)(ap + 16);
        VT_WRITE(vl, vr);
        if (jt + 1 < ntj) VT_LOAD(vr, ZU + (size_t)(jrow0 + 32 * (jt + 1)) * 4096 + 2048 + c0, 4096);
        pv32(o, vb, pa0, pa1);
    }
    LAS float* T = (LAS float*)(F.lds + 65536 + F.wave * 8704);
    u32x4 uu[2][4];
#pragma unroll
    for (int p = 0; p < 2; ++p)
#pragma unroll
        for (int k = 0; k < 4; ++k) { const int idx = lane + 64 * k; uu[p][k] = *(const u32x4*)(ZU + (size_t)(row0 + 16 * p + (idx >> 4)) * 4096 + c0 + 8 * (idx & 15)); }
#pragma unroll
    for (int p = 0; p < 2; ++p) {
#pragma unroll
        for (int rr = 0; rr < 8; ++rr) { const int r = 8 * p + rr, lr = (rr & 3) + 8 * (rr >> 2) + 4 * hi; const float b = bsg[arow0 + 16 * p + lr];
#pragma unroll
            for (int d = 0; d < 4; ++d) T[lr * 136 + 32 * d + r32] = o[d][r] + b; }
#pragma unroll
        for (int k = 0; k < 4; ++k) { const int idx = lane + 64 * k, row = idx >> 4, c8 = idx & 15;
            const f32x4 x0 = *(const LAS f32x4*)(T + row * 136 + 8 * c8), x1 = *(const LAS f32x4*)(T + row * 136 + 8 * c8 + 4); const u32x4 w = uu[p][k];
            float v[8] = {bflo(w.x) * x0.x, bfhi(w.x) * x0.y, bflo(w.y) * x0.z, bfhi(w.y) * x0.w, bflo(w.z) * x1.x, bfhi(w.z) * x1.y, bflo(w.w) * x1.z, bfhi(w.w) * x1.w};
            *(bf16x8*)(US + (size_t)(row0 + 16 * p + row) * 2048 + c0 + 8 * c8) = pack8(v); }
    }
}

#define CONVERT_RANGE(A_, B_, RANK_, NW_) do { \
    LAS float* scr_ = (LAS float*)(F.lds + F.wave * 16640); \
    int ra_ = (A_); asm volatile("" : "+s"(ra_));        \
    const int rb_ = (B_), st_ = (NW_); int it_ = ra_ + (RANK_), base_ = 0; \
    _Pragma("unroll 1") for (int q_ = 0; q_ < 44 && base_ < rb_; ++q_) { \
        const int L_ = q_ < 14 ? 0 : (q_ < 22 ? 1 : (q_ < 36 ? 2 : 3)), r_ = q_ - (q_ < 14 ? 0 : (q_ < 22 ? 14 : (q_ < 36 ? 22 : 36))), e_ = L_ >> 1, odd_ = L_ & 1; \
        const int nmix_ = odd_ ? 2 : 8; \
        const float* W_; bf16_t* WT_; const float* gk_ = nullptr; int K_, N_, mode_ = 0, off_ = 0; \
        if (r_ < 3 || r_ >= 3 + nmix_) { const int f_ = r_ < 3 ? 0 : 1, t_ = r_ < 3 ? r_ : r_ - 3 - nmix_; \
            if (t_ < 2) { W_ = INP((f_ ? 11 : 8) + t_) + (size_t)L_ * DM * FF; WT_ = (bf16_t*)(ws + WS_WGU + (size_t)(L_ * 2 + f_) * SZ_WGU); K_ = DM; N_ = FF; mode_ = 1; off_ = 128 * t_; gk_ = INP(f_ ? 7 : 5) + (size_t)L_ * DM; } \
            else { W_ = INP(f_ ? 13 : 10) + (size_t)L_ * FF * DM; WT_ = (bf16_t*)(ws + WS_WD + (size_t)(L_ * 2 + f_) * SZ_WD); K_ = FF; N_ = DM; } } \
        else if (!odd_) { const int m_ = r_ - 3; \
            if (m_ == 0) { W_ = INP(14) + (size_t)e_ * DM * EVIN; WT_ = (bf16_t*)(ws + WS_EWIN + e_ * SZ_EWIN); K_ = DM; N_ = EVIN; gk_ = INP(6) + (size_t)L_ * DM; } \
            else if (m_ == 1) { W_ = INP(17) + (size_t)e_ * QL * 1536; WT_ = (bf16_t*)(ws + WS_EWQB + e_ * SZ_EWQB); K_ = QL; N_ = 1536; } \
            else if (m_ == 2) { W_ = INP(18) + (size_t)e_ * KVL * 2048; WT_ = (bf16_t*)(ws + WS_EWKVB + e_ * SZ_EWKVB); K_ = KVL; N_ = 2048; } \
            else if (m_ < 7) { const int g_ = m_ - 3; W_ = INP(23) + (size_t)(e_ * 4 + g_) * 256 * 256; WT_ = (bf16_t*)(ws + WS_EPOOLW + e_ * SZ_EPOOLW); K_ = 256; N_ = 256; off_ = g_ * 256; } \
            else { W_ = INP(25) + (size_t)e_ * 2048 * 2048; WT_ = (bf16_t*)(ws + WS_EWOUT + e_ * SZ_SQ); K_ = 2048; N_ = 2048; } } \
        else { const int m_ = r_ - 3; \
            if (m_ == 0) { W_ = INP(26) + (size_t)e_ * DM * 4096; WT_ = (bf16_t*)(ws + WS_OWIN + e_ * SZ_OWIN); K_ = DM; N_ = 4096; gk_ = INP(6) + (size_t)L_ * DM; } \
            else { W_ = INP(30) + (size_t)e_ * 2048 * 2048; WT_ = (bf16_t*)(ws + WS_OWOUT + e_ * SZ_SQ); K_ = 2048; N_ = 2048; } } \
        const int nitems_ = (K_ / 64) * (N_ / 64); \
        const int end_ = (base_ + nitems_ < rb_) ? base_ + nitems_ : rb_; \
        if (it_ < end_) { \
            const RmAny rm_{mode_, off_}; \
            f32x4 vA_[16], vB_[16]; \
            _Pragma("unroll") for (int z_ = 0; z_ < 16; ++z_) vB_[z_] = (f32x4){0.f, 0.f, 0.f, 0.f};        \
            tr_load(vA_, W_, N_, it_ - base_, F.lane); \
            if (it_ + st_ < end_) tr_load(vB_, W_, N_, it_ + st_ - base_, F.lane); \
            while (it_ < end_) { \
                tr_to_lds(vA_, scr_, F.lane); \
                if (it_ + 2 * st_ < end_) tr_load(vA_, W_, N_, it_ + 2 * st_ - base_, F.lane); \
                tr_emit(K_, N_, WT_, rm_, scr_, it_ - base_, F.lane, gk_); \
                it_ += st_; \
                if (it_ >= end_) break; \
                tr_to_lds(vB_, scr_, F.lane); \
                if (it_ + 2 * st_ < end_) tr_load(vB_, W_, N_, it_ + 2 * st_ - base_, F.lane); \
                tr_emit(K_, N_, WT_, rm_, scr_, it_ - base_, F.lane, gk_); \
                it_ += st_; \
            } } \
        base_ += nitems_; \
    } } while (0)

template <int U> __device__ __forceinline__ void cache_convert(const float* src, bf16_t* dst, int W, size_t i0, size_t i1, int rank, int nthr) {
    const size_t per = (size_t)PAST * W, dper = (size_t)LKS * W;
    for (size_t b = i0 + rank; b < i1; b += (size_t)U * nthr) {
        f32x4 x0[U], x1[U];
#pragma unroll
        for (int u = 0; u < U; ++u) { const size_t i = b + (size_t)u * nthr; if (i < i1) { x0[u] = __builtin_nontemporal_load((const f32x4*)(src + i * 8)); x1[u] = __builtin_nontemporal_load((const f32x4*)(src + i * 8 + 4)); } }
#pragma unroll
        for (int u = 0; u < U; ++u) { const size_t i = b + (size_t)u * nthr; if (i < i1) { const size_t el = i * 8; const int s = (int)(el / per); const size_t rem = el - (size_t)s * per;
            float v[8] = {x0[u].x, x0[u].y, x0[u].z, x0[u].w, x1[u].x, x1[u].y, x1[u].z, x1[u].w}; *(bf16x8*)(dst + (size_t)s * dper + rem) = pack8(v); } }
    }
}

constexpr int LAST_SID = 1 + 11 * 8 + 3;
__global__ void __launch_bounds__(NTHR, 2) fwd(Args a) {
    extern __shared__ __attribute__((aligned(16))) unsigned char lds_raw[];
    LAS unsigned char* const LDSP = (LAS unsigned char*)lds_raw;
    const int wave0 = __builtin_amdgcn_readfirstlane((int)threadIdx.x >> 6);
    volatile LAS unsigned* MISC = (volatile LAS unsigned*)(LDSP + MISC_OFF);
    if (threadIdx.x < 64) MISC[threadIdx.x] = 0u;
    __syncthreads();
    unsigned char* const ws0 = a.ws;
    const bool one_launch = (a.hi - a.lo) > 1;
    XcdBarrier bar; bar.bar = (unsigned*)(ws0 + WS_CTL) + CW_BAR; bar.x = 0; bar.st = nullptr;
    if (one_launch) bar = xcd_barrier_post((unsigned*)(ws0 + WS_CTL) + CW_BAR, MISC + 8);
#define SITE_PTRS GAS unsigned char* ws_ = (GAS unsigned char*)ws0; asm volatile("" : "+s"(ws_)); unsigned char* const ws = (unsigned char*)ws_; GAS float* X_ = (GAS float*)a.out; asm volatile("" : "+s"(X_)); float* const X = (float*)X_;     \
    float* const tab = (float*)(ws + WS_TAB); bf16_t* const H = (bf16_t*)(ws + WS_H); bf16_t* const PART = (bf16_t*)(ws + WS_PART); bf16_t* const XB = (bf16_t*)(ws + WS_XB); (void)XB; float* const RS = (float*)(ws + WS_H); (void)RS; float* const SSP = (float*)(ws + WS_H + 65536); (void)SSP;        (void)tab; (void)H; (void)PART;
#define IN(s) (a.lo <= (s) && (s) < a.hi)
#define EVT(k) ((unsigned*)(ws + WS_CTL) + CW_EVT + 64 * (17 * (k)))
#define EVX(k) ((unsigned*)(ws + WS_CTL) + CW_EVT + 64 * (17 * (k) + 1 + (int)bar.x))
#define GATE(k) Gate{EVT(k), (unsigned)F.G, (unsigned*)(ws + WS_CTL) + CW_BAR + XB_TMO, one_launch ? bar.st : nullptr, -1, 32}
#define GATE_K(k, t) Gate{EVT(k), (unsigned)F.G, (unsigned*)(ws + WS_CTL) + CW_BAR + XB_TMO, one_launch ? bar.st : nullptr, (t), 1 << 30}
#define ARRIVE(k) do { if (one_launch) evt_arrive(EVT(k), EVX(k), threadIdx.x == 0 ? bar.st[0] : 0u); else evt_arrive(EVT(k), nullptr, 0u); } while (0)
#define SEAM(s) do { if (one_launch && (s) != LAST_SID) xcd_barrier(bar); } while (0)

    if (EN_PRO && IN(0)) { SITE_PTRS const Frame F = make_frame(LDSP, wave0); const int gtid = F.vcu * NTHR + F.tid, GT = F.G * NTHR; (void)gtid; (void)GT;
        if (PRO_MASK & 2) for (int idx = gtid; idx < M * 32; idx += GT) { const int row = idx >> 5, i = idx & 31; const int pos = row < MP ? row : PAST + ((row - MP) & 31);
            const float inv = __builtin_amdgcn_exp2f(-(float)i * (13.287712379549449f / 32.f));
            const double rev = (double)pos * (double)inv * 0.15915494309189535; const float fr = (float)(rev - __builtin_rint(rev));
            tab[(size_t)row * 64 + i] = __builtin_amdgcn_cosf(fr); tab[(size_t)row * 64 + 32 + i] = __builtin_amdgcn_sinf(fr); }
        cache_convert<4>(INP(2), (bf16_t*)(ws + WS_CKVS), KVL, 0, (size_t)DB * PAST * KVL / 8, gtid, GT);
        cache_convert<4>(INP(3), (bf16_t*)(ws + WS_KPES), ROPE, 0, (size_t)DB * PAST * ROPE / 8, gtid, GT);
        if (PRO_MASK & 8) for (int o = 0; o < 2; ++o) { const float* src = INP(28) + (size_t)o * 8 * 128 * 128; bf16_t* dst = (bf16_t*)(ws + WS_OWS + o * SZ_OWS);
            for (int idx = gtid; idx < 8 * 128 * 128; idx += GT) { const int j = idx & 127, i = (idx >> 7) & 127; dst[idx] = f2bf(j <= i ? src[idx] : 0.f); } }
        if (PRO_MASK & 8) for (int e = 0; e < 2; ++e) { u32x4* d = (u32x4*)(ws + WS_EWIN + e * SZ_EWIN + (size_t)EVIN * DM * 2);
            for (int i = gtid; i < (EVINP - EVIN) * DM * 2 / 16; i += GT) d[i] = (u32x4){0u, 0u, 0u, 0u}; }
#pragma unroll 1
        for (int rg = 0; rg < 12; ++rg) { const int ra = a.plan[24 + 2 * rg], rb = a.plan[25 + 2 * rg]; if (ra < rb) CONVERT_RANGE(ra, rb, F.gw, F.NGW); }
        stat_pass(F, XB, RS, PART, 0.f, INP(0), INP(1), SSP);
        SEAM(0);
    }

    for (int L = 0; L < DEPTH; ++L) {
        for (int part = 0; part < 3; ++part) {
            const int sb = 1 + (L * 3 + part) * 8;
            if (part != 1) {
                const int f = part >> 1;
                if (EN_FFN && IN(sb + 0) && !(L == 0 && part == 0)) { SITE_PTRS const Frame F = make_frame(LDSP, wave0); const int gtid = F.vcu * NTHR + F.tid, GT = F.G * NTHR; (void)gtid; (void)GT; if (F.G == 256) stat_pass2(F, XB, RS, PART, part == 0 ? 0.5f : 1.0f, SSP); else stat_pass(F, XB, RS, PART, part == 0 ? 0.5f : 1.0f, nullptr, nullptr, SSP); ARRIVE(L * 3 + part); }
                if (EN_FFN && IN(sb + 1)) { SITE_PTRS const Frame F = make_frame(LDSP, wave0); const int gtid = F.vcu * NTHR + F.tid, GT = F.G * NTHR; (void)gtid; (void)GT;
                    pg8::Gemm g{XB, (const bf16_t*)(ws + WS_WGU + (size_t)(L * 2 + f) * SZ_WGU), M, 2 * FF, DM, DM, DM, 0};
                    pg8::StaticOrder S; S.init(M, 2 * FF, F.G, (int)blockIdx.x, DM);
                    pg8::EpiSwiGLU E{(bf16_t*)(ws + WS_ACT), FF, RS, (LAS float*)(F.lds + AUX_OFF + 4096)};
                    pg8::gemm_phase<pg8::EpiSwiGLU, pg8::StaticOrder>(F.lds, g, S, E, F.tid, (L == 0 && part == 0) ? Gate{nullptr, 0u, nullptr, nullptr, -1, 32} : GATE(L * 3 + part));
                    { const int k = 3 * L + (part ? 2 : 0), c = (int)blockIdx.x;
                      if (c >= 48) CONVERT_RANGE(a.plan[k], a.plan[12 + k], (c - 48) * 8 + F.wave, 208 * 8); }
                    SEAM(sb + 1);
                }
                if (EN_FFN && IN(sb + 2)) { SITE_PTRS const Frame F = make_frame(LDSP, wave0); const int gtid = F.vcu * NTHR + F.tid, GT = F.G * NTHR; (void)gtid; (void)GT;
                    pg8::Gemm g{(const bf16_t*)(ws + WS_ACT), (const bf16_t*)(ws + WS_WD + (size_t)(L * 2 + f) * SZ_WD), M, DM, FF, FF, FF, 0};
                    pg8::SplitOrder S; S.init(DM, F.G, (int)blockIdx.x, FF);
                    pg8::EpiResid E{XB, DM, 0.5f, PART, FF / 64, (L == DEPTH - 1 && part == 2) ? X : nullptr, SSP};
                    pg8::gemm_phase<pg8::EpiResid, pg8::SplitOrder>(F.lds, g, S, E, F.tid);
                    SEAM(sb + 2);
                }
            } else {
                if (EN_FFN && IN(sb + 0)) { SITE_PTRS const Frame F = make_frame(LDSP, wave0); const int gtid = F.vcu * NTHR + F.tid, GT = F.G * NTHR; (void)gtid; (void)GT; if (F.G == 256) stat_pass2(F, XB, RS, PART, 0.5f, SSP); else stat_pass(F, XB, RS, PART, 0.5f, nullptr, nullptr, SSP); ARRIVE(L * 3 + 1); }
                const int e = L >> 1;
                if ((L & 1) == 0) {
#define Z ((float*)(ws + WS_Z))
#define POOLED ((bf16_t*)(ws + WS_POOLED))
#define QAN ((bf16_t*)(ws + WS_QAN))
#define Qb ((bf16_t*)(ws + WS_Q))
#define CKVP ((bf16_t*)(ws + WS_CKVP))
#define KPEP ((bf16_t*)(ws + WS_KPEP))
#define CKVS ((bf16_t*)(ws + WS_CKVS + e * SZ_CKVS))
#define KPES ((bf16_t*)(ws + WS_KPES + e * SZ_KPES))
#define KVP ((bf16_t*)(ws + WS_KVP))
#define KVS ((bf16_t*)(ws + WS_BIG))
#define MIX ((bf16_t*)(ws + WS_MIX))
                    if (EN_EVG && IN(sb + 1)) { SITE_PTRS const Frame F = make_frame(LDSP, wave0); const int gtid = F.vcu * NTHR + F.tid, GT = F.G * NTHR; (void)gtid; (void)GT;
                        pg8::Gemm g{XB, (const bf16_t*)(ws + WS_EWIN + e * SZ_EWIN), M, EVINP, DM, DM, DM, 0};
                        pg8::StaticOrder S; S.init(M, EVINP, F.G, (int)blockIdx.x, DM);
                        pg8::EpiF32 E{Z, EVINP, RS, (LAS float*)(F.lds + AUX_OFF + 4096)};
                        pg8::gemm_phase<pg8::EpiF32, pg8::StaticOrder>(F.lds, g, S, E, F.tid, GATE(L * 3 + 1));
                        { const int k = 3 * L + 1, c = (int)blockIdx.x; if (c >= 68) CONVERT_RANGE(a.plan[k], a.plan[12 + k], (c - 68) * 8 + F.wave, 188 * 8); }
                        SEAM(sb + 1);
                    }
                    if (EN_EVMID && IN(sb + 2)) { SITE_PTRS const Frame F = make_frame(LDSP, wave0); const int gtid = F.vcu * NTHR + F.tid, GT = F.G * NTHR; (void)gtid; (void)GT;
                        const float* gqa = INP(15) + e * QL; const float* gkva = INP(16) + e * KVL; const float* gkpe = INP(22) + e * ROPE;
                        for (int row = F.gw; row < M; row += 2 * F.NGW) {
                            const int row2 = row + F.NGW; const bool two = row2 < M; const int lane = F.lane;
                            f32x4 zq0[2], zq1[2], zk0[2], zk1[2]; float zp[2];
                            zq0[1] = zq1[1] = zk0[1] = zk1[1] = (f32x4){0.f, 0.f, 0.f, 0.f}; zp[1] = 0.f;
#pragma unroll
                            for (int q = 0; q < 2; ++q) if (q == 0 || two) { const float* zr = Z + (size_t)(q ? row2 : row) * EVINP;
                                zq0[q] = *(const f32x4*)(zr + 1024 + 8 * lane); zq1[q] = *(const f32x4*)(zr + 1028 + 8 * lane);
                                zk0[q] = *(const f32x4*)(zr + 1536 + 8 * lane); zk1[q] = *(const f32x4*)(zr + 1540 + 8 * lane); zp[q] = zr[2048 + lane]; }
                            const f32x4 ga0 = *(const f32x4*)(gqa + 8 * lane), ga1 = *(const f32x4*)(gqa + 8 * lane + 4), gb0 = *(const f32x4*)(gkva + 8 * lane), gb1 = *(const f32x4*)(gkva + 8 * lane + 4);
                            const float gpe = gkpe[lane];
#pragma unroll
                            for (int q = 0; q < 2; ++q) if (q == 0 || two) { const int rw = q ? row2 : row;
                                const f32x4 q0 = zq0[q], q1 = zq1[q], k0 = zk0[q], k1 = zk1[q]; const float pr = zp[q];
                                const float rq = rsq(wave_sum((q0.x * q0.x + q0.y * q0.y) + (q0.z * q0.z + q0.w * q0.w) + (q1.x * q1.x + q1.y * q1.y) + (q1.z * q1.z + q1.w * q1.w)) * (1.f / QL) + EPS);
                                const float rk = rsq(wave_sum((k0.x * k0.x + k0.y * k0.y) + (k0.z * k0.z + k0.w * k0.w) + (k1.x * k1.x + k1.y * k1.y) + (k1.z * k1.z + k1.w * k1.w)) * (1.f / KVL) + EPS);
                                const float rp = rsq(wave_sum(pr * pr) * (1.f / ROPE) + EPS);
                                { float v[8] = {q0.x * rq * ga0.x, q0.y * rq * ga0.y, q0.z * rq * ga0.z, q0.w * rq * ga0.w, q1.x * rq * ga1.x, q1.y * rq * ga1.y, q1.z * rq * ga1.z, q1.w * rq * ga1.w};
                                  *(bf16x8*)(QAN + (size_t)rw * QL + 8 * lane) = pack8(v); }
                                const f32x4 c0 = {k0.x * rk * gb0.x, k0.y * rk * gb0.y, k0.z * rk * gb0.z, k0.w * rk * gb0.w}, c1 = {k1.x * rk * gb1.x, k1.y * rk * gb1.y, k1.z * rk * gb1.z, k1.w * rk * gb1.w};
                                const float pn = pr * rp * gpe; const float other = xor32_other(pn, lane);
                                const float cs = tab[(size_t)rw * 64 + (lane & 31)], sn = tab[(size_t)rw * 64 + 32 + (lane & 31)];
                                const float pe = lane < 32 ? pn * cs - other * sn : other * sn + pn * cs;
                                float* oc; float* op; bf16_t* bc; bf16_t* bp;
                                if (rw < MP) { oc = X + O_CKVP + ((size_t)e * MP + rw) * KVL; op = X + O_KPEP + ((size_t)e * MP + rw) * ROPE; bc = CKVP + (size_t)rw * KVL; bp = KPEP + (size_t)rw * ROPE; }
                                else { const int sr = rw - MP, s = sr >> 5, i = sr & 31; oc = X + O_CKVS + ((size_t)e * MS + sr) * KVL; op = X + O_KPES + ((size_t)e * MS + sr) * ROPE;
                                       bc = CKVS + ((size_t)s * LKS + PAST + i) * KVL; bp = KPES + ((size_t)s * LKS + PAST + i) * ROPE; }
                                *(f32x4*)(oc + 8 * lane) = c0; *(f32x4*)(oc + 8 * lane + 4) = c1;
                                { float v[8] = {c0.x, c0.y, c0.z, c0.w, c1.x, c1.y, c1.z, c1.w}; *(bf16x8*)(bc + 8 * lane) = pack8(v); }
                                op[lane] = pe; bp[lane] = f2bf(pe);
                            }
                        }
                        const float* hist = INP(4) + (size_t)e * DB * 15 * POOLD;
                        for (int it = F.vcu; it < (M / 16) * 2; it += F.G) {
                            const int rb = it >> 1, col = (it & 1) * 512 + F.tid, gq = col >> 8;
                            const int row0 = rb * 16; const bool prm = row0 < MP;
                            const int seq0 = prm ? 0 : MP + ((row0 - MP) & ~31);
                            const int l0 = row0 - seq0; const int s = prm ? 0 : (row0 - MP) >> 5;
                            const float* hs = hist + (size_t)s * 15 * POOLD + col;
                            const float* zc = Z + (size_t)seq0 * EVINP + col; bf16_t* pc = POOLED + (size_t)seq0 * POOLD + col;
                            if (gq == 0) pool16<2>(zc, hs, pc, l0, prm); else if (gq == 1) pool16<4>(zc, hs, pc, l0, prm); else if (gq == 2) pool16<8>(zc, hs, pc, l0, prm); else pool16<16>(zc, hs, pc, l0, prm);
                        }
                        for (int idx = gtid; idx < 33 * 15 * POOLD; idx += GT) { const int col = idx & 1023, j = (idx >> 10) % 15, sq = idx / (15 * POOLD);
                            if (sq == 0) X[O_POOLP + ((size_t)e * 15 + j) * POOLD + col] = Z[(size_t)(MP - 15 + j) * EVINP + col];
                            else { const int s = sq - 1; X[O_POOLS + (((size_t)e * DB + s) * 15 + j) * POOLD + col] = Z[(size_t)(MP + 32 * s + 17 + j) * EVINP + col]; } }
                        SEAM(sb + 2);
                    }
                    if (EN_EVG && IN(sb + 3)) { SITE_PTRS const Frame F = make_frame(LDSP, wave0); const int gtid = F.vcu * NTHR + F.tid, GT = F.G * NTHR; (void)gtid; (void)GT;
                        { pg8::Gemm g{POOLED, (const bf16_t*)(ws + WS_EPOOLW + e * SZ_EPOOLW), M, 1024, 256, 1024, 256, 512};
                          pg8::StaticOrder S; S.init(M, 1024, F.G, (int)((blockIdx.x + 144) % F.G), 256);
                          pg8::EpiBf16<0> E{MIX, 2048, 0, INP(24) + e * POOLD, nullptr, nullptr, nullptr};
                          pg8::gemm_phase<pg8::EpiBf16<0>, pg8::StaticOrder>(F.lds, g, S, E, F.tid); }
                        { pg8::Gemm g{QAN, (const bf16_t*)(ws + WS_EWQB + e * SZ_EWQB), M, 1536, QL, QL, QL, 0};
                          pg8::StaticOrder S; S.init(M, 1536, F.G, (int)((blockIdx.x + 216) % F.G), QL);
                          pg8::EpiBf16<0> E{Qb, 1536, 0, nullptr, nullptr, nullptr, nullptr};
                          pg8::gemm_phase<pg8::EpiBf16<0>, pg8::StaticOrder>(F.lds, g, S, E, F.tid); }
                        { pg8::Gemm g{CKVP, (const bf16_t*)(ws + WS_EWKVB + e * SZ_EWKVB), MP, 2048, KVL, KVL, KVL, 0};
                          pg8::StaticOrder S; S.init(MP, 2048, F.G, (int)blockIdx.x, KVL);
                          pg8::EpiKV E{KVP, 2048, INP(21) + e * NOPE, (LAS float*)(F.lds + AUX_OFF)};
                          pg8::gemm_phase<pg8::EpiKV, pg8::StaticOrder>(F.lds, g, S, E, F.tid); }
                        { pg8::Gemm g{CKVS, (const bf16_t*)(ws + WS_EWKVB + e * SZ_EWKVB), MKS, 2048, KVL, KVL, KVL, 0};
                          pg8::StaticOrder S; S.init(MKS, 2048, F.G, (int)blockIdx.x, KVL);
                          pg8::EpiKV E{KVS, 2048, INP(21) + e * NOPE, (LAS float*)(F.lds + AUX_OFF)};
                          pg8::gemm_phase<pg8::EpiKV, pg8::StaticOrder>(F.lds, g, S, E, F.tid); }
                        SEAM(sb + 3);
                    }
                    if (EN_ATTN && IN(sb + 5)) { SITE_PTRS const Frame F = make_frame(LDSP, wave0); const int gtid = F.vcu * NTHR + F.tid, GT = F.G * NTHR; (void)gtid; (void)GT;
                        const float* gqn = INP(19) + e * NOPE; const float* gqp = INP(20) + e * ROPE;
                        const int sp = F.vcu % 3;
#pragma unroll 1
                        for (int ph = 0; ph < 3; ++ph) {
                            if (ph == sp) { AttnUnit U; const int s = F.vcu & 31; U.qrow0 = MP + 32 * s; U.h = F.vcu >> 5; U.ntiles = LKS / 32; U.kv = KVS + (size_t)s * LKS * 2048; U.kpe = KPES + (size_t)s * LKS * ROPE;
                                attn_unit(F, U, Qb, tab, gqn, gqp, MIX); }
                            else { const int half = ph - (ph > sp ? 1 : 0), pr = F.vcu & 31;
                                attn_unit128(F, F.vcu >> 5, half ? 63 - pr : pr, Qb, KVP, KPEP, tab, gqn, gqp, MIX); }
                            if (L == 0 && ph == 0) {
                                const size_t n1 = (size_t)DB * PAST * KVL / 8, n2 = (size_t)DB * PAST * ROPE / 8;
                                cache_convert<8>(INP(2) + (size_t)DB * PAST * KVL, (bf16_t*)(ws + WS_CKVS + SZ_CKVS), KVL, n1 * F.vcu / F.G, n1 * (F.vcu + 1) / F.G, F.tid, NTHR);
                                cache_convert<8>(INP(3) + (size_t)DB * PAST * ROPE, (bf16_t*)(ws + WS_KPES + SZ_KPES), ROPE, n2 * F.vcu / F.G, n2 * (F.vcu + 1) / F.G, F.tid, NTHR); }
                        }
                        ARRIVE(12 + e);
                    }
                    if (EN_EVG && IN(sb + 6)) { SITE_PTRS const Frame F = make_frame(LDSP, wave0); const int gtid = F.vcu * NTHR + F.tid, GT = F.G * NTHR; (void)gtid; (void)GT;
                        pg8::Gemm g{MIX, (const bf16_t*)(ws + WS_EWOUT + e * SZ_SQ), M, DM, 2048, 2048, 2048, 0};
                        pg8::SplitOrder S; S.init(DM, F.G, (int)blockIdx.x, 2048);
                        pg8::EpiResid E{XB, DM, 1.0f, PART, 2048 / 64, nullptr, SSP};
                        pg8::gemm_phase<pg8::EpiResid, pg8::SplitOrder>(F.lds, g, S, E, F.tid, GATE_K(12 + e, 14));
                        SEAM(sb + 6);
                    }
                } else {
#define ZO ((bf16_t*)(ws + WS_Z))
#define VN ((bf16_t*)(ws + WS_VN))
#define US ((bf16_t*)(ws + WS_US))
                    if (EN_ODDG && IN(sb + 1)) { SITE_PTRS const Frame F = make_frame(LDSP, wave0); const int gtid = F.vcu * NTHR + F.tid, GT = F.G * NTHR; (void)gtid; (void)GT;
                        pg8::Gemm g{XB, (const bf16_t*)(ws + WS_OWIN + e * SZ_OWIN), M, 4096, DM, DM, DM, 0};
                        pg8::StaticOrder S; S.init(M, 4096, F.G, (int)blockIdx.x, DM);
                        pg8::EpiBf16<1> E{ZO, 4096, 0, nullptr, RS, (LAS float*)(F.lds + AUX_OFF + 4096), (float*)(ws + WS_H + 2097152)};
                        pg8::gemm_phase<pg8::EpiBf16<1>, pg8::StaticOrder>(F.lds, g, S, E, F.tid, GATE(L * 3 + 1));
                        { const int k = 3 * L + 1, c = (int)blockIdx.x; if (c >= 64) CONVERT_RANGE(a.plan[k], a.plan[12 + k], (c - 64) * 8 + F.wave, 192 * 8); }
                        SEAM(sb + 1);
                    }
                    if (EN_GATE && IN(sb + 5)) { SITE_PTRS const Frame F = make_frame(LDSP, wave0); const int gtid = F.vcu * NTHR + F.tid, GT = F.G * NTHR; (void)gtid; (void)GT;
                        const bf16_t* wsb = (const bf16_t*)(ws + WS_OWS + e * SZ_OWS); const float* bs = INP(29) + (size_t)e * 8 * 128;
                        const float* SSV = (const float*)(ws + WS_H + 2097152); const float* gv = INP(27) + (size_t)e * GATE;
                        for (int id = F.gw; id < 64 * 8 * 2 * 2; id += F.NGW) {
                            const int k = id & 1, rest = id >> 1, ch = rest & 1, g = (rest >> 1) & 7, n = rest >> 4;
#pragma unroll 1
                            for (int half = 0; half < 2; ++half) { const int ib = half ? 3 - k : k;
                                gate_item(F, 128 * n + 32 * ib, 32 * ib, 128 * n, ib + 1, g, 256 * g + 128 * ch, wsb + (size_t)g * 128 * 128, bs + g * 128, SSV, gv, ZO, US, nullptr); }
                        }
                        for (int id = F.gw; id < DB * 8 * 2; id += F.NGW) {
                            const int ch = id & 1, g = (id >> 1) & 7, s = id >> 4;
                            gate_item(F, MP + 32 * s, 0, MP + 32 * s, 1, g, 256 * g + 128 * ch, wsb + (size_t)g * 128 * 128, bs + g * 128, SSV, gv, ZO, US, X + O_VS + ((size_t)e * MS + 32 * s) * GATE);
                        }
                        SEAM(sb + 5);
                    }
                    if (EN_ODDG && IN(sb + 6)) { SITE_PTRS const Frame F = make_frame(LDSP, wave0); const int gtid = F.vcu * NTHR + F.tid, GT = F.G * NTHR; (void)gtid; (void)GT;
                        pg8::Gemm g{US, (const bf16_t*)(ws + WS_OWOUT + e * SZ_SQ), M, DM, 2048, 2048, 2048, 0};
                        pg8::SplitOrder S; S.init(DM, F.G, (int)blockIdx.x, 2048);
                        pg8::EpiResid E{XB, DM, 1.0f, PART, 2048 / 64, nullptr, SSP};
                        pg8::gemm_phase<pg8::EpiResid, pg8::SplitOrder>(F.lds, g, S, E, F.tid);
                        SEAM(sb + 6);
                    }
                }
            }
        }
    }
    if (IN(LAST_SID)) { SITE_PTRS const Frame F = make_frame(LDSP, wave0);
        for (int row = MP + F.gw; row < M; row += F.NGW) {
            const u32x2* xr = (const u32x2*)(XB + (size_t)row * DM) + F.lane; f32x4* yr = (f32x4*)(X + (size_t)row * DM) + F.lane;
            const u32x2* pr = (const u32x2*)(PART + (size_t)(row - MP) * DM) + F.lane;
#pragma unroll
            for (int j = 0; j < 8; ++j) { f32x4 t = {0.f, 0.f, 0.f, 0.f};
#pragma unroll
                for (int sl = 0; sl < 8; ++sl) t += bf4(pr[(size_t)sl * (1024 * 2048 / 4) + 64 * j]);
                yr[64 * j] = bf4(xr[64 * j]) + t * 0.5f; }
        }
    }
#undef IN
#undef SEAM
#undef Z
#undef POOLED
#undef QAN
#undef Qb
#undef CKVP
#undef KPEP
#undef CKVS
#undef KPES
#undef KVP
#undef KVS
#undef MIX
#undef ZO
#undef VN
#undef US
}

extern "C" void kernel_launch(void* const* d_in, const int* in_sizes, int n_in, void* d_out, int out_size, void* d_ws, size_t ws_size, hipStream_t stream) {
    static int grid = 0;
    if (grid == 0) {
        if (n_in != 31 || out_size != (int)O_END || ws_size < WS_END) { fprintf(stderr, "kernel_launch: unexpected shapes: n_in %d out %d ws %zu (need %zu)\n", n_in, out_size, ws_size, (size_t)WS_END); grid = -1; return; }
        int dev = 0, cus = 0;
        if (hipGetDevice(&dev) != hipSuccess || hipDeviceGetAttribute(&cus, hipDeviceAttributeMultiprocessorCount, dev) != hipSuccess) { grid = -1; return; }
        if (hipFuncSetAttribute((const void*)fwd, hipFuncAttributeMaxDynamicSharedMemorySize, LDS_BYTES) != hipSuccess) { fprintf(stderr, "kernel_launch: hipFuncSetAttribute failed\n"); grid = -1; return; }
        int per_cu = 0; (void)hipOccupancyMaxActiveBlocksPerMultiprocessor(&per_cu, (const void*)fwd, NTHR, LDS_BYTES); (void)hipGetLastError();
        grid = cus;
        if (grid != 256) fprintf(stderr, "kernel_launch: %d CUs (built for 256)\n", grid);
    }
    if (grid < 0) return;
    (void)hipMemsetAsync((char*)d_ws + WS_CTL, 0, CTL_BYTES, stream);
    Args a{};
    for (int i = 0; i < 31; ++i) a.in[i] = (const float*)d_in[i];
    a.out = (float*)d_out; a.ws = (unsigned char*)d_ws;
    {
        static const int slot[12][2] = {{5632, 12288}, {12288, 18304}, {18304, 24960}, {25120, 31776}, {31776, 37920}, {37920, 44576}, {45088, 51744}, {51744, 57760}, {57760, 64416}, {64576, 71232}, {71232, 77376}, {77376, 78912}};
        static const int pro[12][2] = {{0, 5632}, {24960, 25120}, {44576, 45088}, {64416, 64576}, {0, 0}, {0, 0}, {0, 0}, {0, 0}, {0, 0}, {0, 0}, {0, 0}, {0, 0}};
        for (int k = 0; k < 12; ++k) { a.plan[k] = slot[k][0]; a.plan[12 + k] = slot[k][1]; a.plan[24 + 2 * k] = pro[k][0]; a.plan[25 + 2 * k] = pro[k][1]; } }
#if MK_PER_STEP
    for (int s = 0; s <= LAST_SID; ++s) {
        if (s > 0) { const int q = (s - 1) / 8, k = (s - 1) % 8, part = q % 3, L = q / 3;
            if (part != 1) { if (k > 2 && s != LAST_SID) continue; } else if ((L & 1) == 0) { if (k == 4 || k > 6) continue; } else { if (k == 2 || k == 3 || k == 4 || k > 6) continue; } }
        a.lo = s; a.hi = s + 1;
        hipLaunchKernelGGL(fwd, dim3(grid), dim3(NTHR), LDS_BYTES, stream, a);
    }
#else
    a.lo = 0; a.hi = LAST_SID + 1;
    hipLaunchKernelGGL(fwd, dim3(grid), dim3(NTHR), LDS_BYTES, stream, a);
#endif
    const hipError_t le = hipPeekAtLastError();
    if (le != hipSuccess) fprintf(stderr, "kernel_launch: launch failed: %s\n", hipGetErrorName(le));
}
```

```cpp
#include <hip/hip_runtime.h>
#include <cstdio>
#include <cstdint>

#ifndef MK_PER_STEP
#define MK_PER_STEP 0
#endif
#ifndef PRO_MASK
#define PRO_MASK 0xffff
#endif
#ifndef EN_PRO
#define EN_PRO 1
#define EN_FFN 1
#define EN_EVG 1
#define EN_EVMID 1
#define EN_ATTN 1
#define EN_ODDG 1
#define EN_ODDMID 1
#define EN_GATE 1
#endif

#define GAS __attribute__((address_space(1)))
#define LAS __attribute__((address_space(3)))
typedef unsigned short bf16_t;
typedef short bf16x8 __attribute__((ext_vector_type(8)));
typedef short s16x4 __attribute__((ext_vector_type(4)));
typedef float f32x4 __attribute__((ext_vector_type(4)));
typedef float f32x2 __attribute__((ext_vector_type(2)));
typedef float f32x16 __attribute__((ext_vector_type(16)));
typedef unsigned u32x4 __attribute__((ext_vector_type(4)));
typedef unsigned u32x2 __attribute__((ext_vector_type(2)));

constexpr int DM = 2048, SEQ = 8192, DEPTH = 4, DB = 32, DS = 32, PAST = 2048, FF = 5632;
constexpr int MP = SEQ, MS = DB * DS, M = MP + MS;
constexpr int LKS = PAST + DS, MKS = DB * LKS;
constexpr int POOLD = 1024, QL = 512, KVL = 512, ROPE = 64, NOPE = 128, VH = 128, QKH = 192, NH = 8;
constexpr int EVIN = 2112, EVINP = 2304, GATE = 2048;
constexpr float EPS = 1e-6f;
constexpr float ATTN_C = 0.07216878364870322f * 1.4426950408889634f;

constexpr size_t O_YP = 0, O_YS = 16777216, O_CKVP = 18874368, O_KPEP = 27262976, O_POOLP = 28311552, O_CKVS = 28342272, O_KPES = 29390848, O_POOLS = 29521920, O_VS = 30504960, O_END = 34699264;

constexpr size_t al256(size_t x) { return (x + 255) / 256 * 256; }
constexpr size_t WS_CTL = 0, CTL_BYTES = 1u << 20;
constexpr size_t WS_TAB = WS_CTL + CTL_BYTES;
constexpr size_t WS_WGU = WS_TAB + (size_t)M * 64 * 4;
constexpr size_t SZ_WGU = (size_t)2 * FF * DM * 2;
constexpr size_t WS_WD = WS_WGU + 8 * SZ_WGU;
constexpr size_t SZ_WD = (size_t)DM * FF * 2;
constexpr size_t WS_EWIN = WS_WD + 8 * SZ_WD;
constexpr size_t SZ_EWIN = (size_t)EVINP * DM * 2;
constexpr size_t WS_EWQB = WS_EWIN + 2 * SZ_EWIN;
constexpr size_t SZ_EWQB = (size_t)1536 * 512 * 2;
constexpr size_t WS_EWKVB = WS_EWQB + 2 * SZ_EWQB;
constexpr size_t SZ_EWKVB = (size_t)2048 * 512 * 2;
constexpr size_t WS_EPOOLW = WS_EWKVB + 2 * SZ_EWKVB;
constexpr size_t SZ_EPOOLW = (size_t)1024 * 256 * 2;
constexpr size_t WS_EWOUT = WS_EPOOLW + 2 * SZ_EPOOLW;
constexpr size_t SZ_SQ = (size_t)2048 * 2048 * 2;
constexpr size_t WS_OWIN = WS_EWOUT + 2 * SZ_SQ;
constexpr size_t SZ_OWIN = (size_t)4096 * 2048 * 2;
constexpr size_t WS_OWS = WS_OWIN + 2 * SZ_OWIN;
constexpr size_t SZ_OWS = (size_t)8 * 128 * 128 * 2;
constexpr size_t WS_OWOUT = WS_OWS + 2 * SZ_OWS;
constexpr size_t WS_H = WS_OWOUT + 2 * SZ_SQ;
constexpr size_t WS_BIG = WS_H + (size_t)M * DM * 2;
constexpr size_t SZ_BIG = (size_t)MKS * 2048 * 2;
constexpr size_t WS_ACT = WS_BIG, WS_Z = WS_BIG + (size_t)M * FF * 2;
static_assert(WS_Z + (size_t)M * EVINP * 4 <= WS_BIG + SZ_BIG, "overlay");
constexpr size_t WS_POOLED = WS_BIG + SZ_BIG;
constexpr size_t WS_QAN = WS_POOLED + (size_t)M * 1024 * 2;
constexpr size_t WS_Q = WS_QAN + (size_t)M * 512 * 2;
constexpr size_t WS_CKVP = WS_Q + (size_t)M * 1536 * 2;
constexpr size_t WS_KPEP = WS_CKVP + (size_t)MP * 512 * 2;
constexpr size_t WS_CKVS = WS_KPEP + (size_t)MP * 64 * 2;
constexpr size_t SZ_CKVS = (size_t)MKS * 512 * 2;
constexpr size_t WS_KPES = WS_CKVS + 2 * SZ_CKVS;
constexpr size_t SZ_KPES = (size_t)MKS * 64 * 2;
constexpr size_t WS_KVP = WS_KPES + 2 * SZ_KPES;
constexpr size_t WS_MIX = WS_KVP + (size_t)MP * 2048 * 2;
constexpr size_t WS_VN = WS_MIX + (size_t)M * 2048 * 2;
constexpr size_t WS_US = WS_VN + (size_t)M * 2048 * 2;
constexpr size_t WS_PART = WS_US + (size_t)M * 2048 * 2;
constexpr size_t WS_XB = WS_PART + (size_t)8 * 1024 * 2048 * 4;
constexpr size_t WS_END = WS_XB + (size_t)M * DM * 2;

constexpr int CW_BAR = 4096, CW_EVT = 16384;

constexpr int RING_BYTES = 131072, AUX_OFF = RING_BYTES, MISC_OFF = AUX_OFF + 8192, LDS_BYTES = 147456;
constexpr int NWAVES = 8, NTHR = 512;

#define LDS_WAIT() asm volatile("s_waitcnt lgkmcnt(0)" ::: "memory")
#define VM_WAIT() asm volatile("s_waitcnt vmcnt(0)" ::: "memory")
#define SBAR() __builtin_amdgcn_sched_barrier(0)

__device__ __forceinline__ unsigned cvt_pk_bf16(float lo, float hi) { unsigned r; asm volatile("v_cvt_pk_bf16_f32 %0, %1, %2" : "=v"(r) : "v"(lo), "v"(hi)); return r; }
__device__ __forceinline__ float bflo(unsigned w) { return __uint_as_float(w << 16); }
__device__ __forceinline__ float bfhi(unsigned w) { return __uint_as_float(w & 0xffff0000u); }
__device__ __forceinline__ float bf1(short s) { return __uint_as_float(((unsigned)(unsigned short)s) << 16); }
__device__ __forceinline__ bf16_t f2bf(float f) { return (bf16_t)(cvt_pk_bf16(f, 0.f) & 0xffffu); }
template <int CTRL> __device__ __forceinline__ float dpp_f(float v) { return __builtin_bit_cast(float, __builtin_amdgcn_update_dpp(0, __builtin_bit_cast(int, v), CTRL, 0xf, 0xf, true)); }
__device__ __forceinline__ float xor32_sum(float v) { auto r = __builtin_amdgcn_permlane32_swap(__float_as_uint(v), __float_as_uint(v), false, false); return __uint_as_float(r[0]) + __uint_as_float(r[1]); }
__device__ __forceinline__ float xor32_max(float v) { auto r = __builtin_amdgcn_permlane32_swap(__float_as_uint(v), __float_as_uint(v), false, false); return fmaxf(__uint_as_float(r[0]), __uint_as_float(r[1])); }
__device__ __forceinline__ float xor32_other(float v, int lane) { auto r = __builtin_amdgcn_permlane32_swap(__float_as_uint(v), __float_as_uint(v), false, false); return __uint_as_float(lane < 32 ? r[1] : r[0]); }
__device__ __forceinline__ float sum16(float v) {
    v += dpp_f<0xB1>(v);
    v += dpp_f<0x4E>(v);
    v += dpp_f<0x141>(v);
    v += dpp_f<0x140>(v);
    return v;
}
__device__ __forceinline__ float wave_sum(float v) {
    v = sum16(v);
    { auto r = __builtin_amdgcn_permlane16_swap(__float_as_uint(v), __float_as_uint(v), false, false); v = __uint_as_float(r[0]) + __uint_as_float(r[1]); }
    return xor32_sum(v);
}
__device__ __forceinline__ float rsq(float x) { return 1.0f / sqrtf(x); }
__device__ __forceinline__ bf16x8 pack8(const float* v) { u32x4 w; w.x = cvt_pk_bf16(v[0], v[1]); w.y = cvt_pk_bf16(v[2], v[3]); w.z = cvt_pk_bf16(v[4], v[5]); w.w = cvt_pk_bf16(v[6], v[7]); return __builtin_bit_cast(bf16x8, w); }

struct Gate { unsigned* evt; unsigned need; unsigned* tmo; volatile LAS unsigned* st; int tg, pm0; };
__device__ __forceinline__ void evt_arrive(unsigned* e, unsigned* ex, unsigned nloc) {
    asm volatile("s_waitcnt vmcnt(0)" ::: "memory");
    __syncthreads();
    if (threadIdx.x == 0) {
        bool pub = true;
        if (ex) { const unsigned old = __hip_atomic_fetch_add(ex, 1u, __ATOMIC_RELAXED, __HIP_MEMORY_SCOPE_AGENT); pub = (old + 1u == nloc); }
        if (pub) { __builtin_amdgcn_fence(__ATOMIC_RELEASE, "agent"); asm volatile("s_waitcnt vmcnt(0)" ::: "memory");
            (void)__hip_atomic_fetch_add(e, 1u, __ATOMIC_RELAXED, __HIP_MEMORY_SCOPE_AGENT); }
    }
}
__device__ __forceinline__ void evt_wait_one(const Gate& g) {
    const unsigned need = g.st ? g.st[1] : g.need;
    unsigned sp = 0;
    while (__hip_atomic_load(g.evt, __ATOMIC_RELAXED, __HIP_MEMORY_SCOPE_AGENT) < need) { __builtin_amdgcn_s_sleep(1);
        if ((++sp & 255u) == 0u) { if (__hip_atomic_load(g.tmo, __ATOMIC_RELAXED, __HIP_MEMORY_SCOPE_AGENT)) break; if (sp > (1u << 18)) { atomicAdd(g.tmo, 1u); break; } } }
    __builtin_amdgcn_fence(__ATOMIC_ACQUIRE, "agent");
    asm volatile("s_waitcnt vmcnt(0)" ::: "memory");
}

namespace pg8 {
constexpr int BM = 256, BK = 64, HALF = 128, HTB = HALF * BK * 2, STAGE_BYTES = 8 * HTB, NXCD = 8, WGM = 8;
__host__ __device__ __forceinline__ int lds_byte(int r, int c) { const int st = (r >> 4) * 2 + (c >> 5), rr = r & 15, cc = c & 31, ob = rr * 64 + cc * 2; return st * 1024 + (ob ^ (((ob >> 9) & 1) << 5)); }
__host__ __device__ __forceinline__ void stage_rc(int b, int& R, int& C) { const int st = b / 1024, sb = b % 1024, swz = sb ^ (((sb >> 9) & 1) << 5); R = (st >> 1) * 16 + swz / 64; C = (st & 1) * 32 + (swz % 64) / 2; }
__host__ __device__ __forceinline__ int perm32(int rho) { const int n = rho >> 4, i = rho & 15; return 8 * (i >> 2) + 4 * n + (i & 3); }
struct Unit { int pm, pn, kt0, nkt; };
struct Gemm { const bf16_t* A; const bf16_t* Bt; int M, N, K, lda, ldb, apn; };
struct StaticOrder {
    int nM, nN, nwg, G, c, ntk;
    __host__ __device__ void init(int M_, int N_, int G_, int c_, int K_) { nM = M_ / BM; nN = N_ / BM; nwg = nM * nN; G = G_; c = c_; ntk = K_ / BK; }
    __host__ __device__ bool next(int i, Unit& u) const {
        u.kt0 = 0; u.nkt = ntk;
        const long L = (long)i * G + c; if (L >= nwg) return false;
        int wgid = (int)L; { const int q = nwg / NXCD, r = nwg % NXCD, xcd = wgid % NXCD, off = wgid / NXCD; wgid = (xcd < r ? xcd * (q + 1) : r * (q + 1) + (xcd - r) * q) + off; }
        const int nig = WGM * nN, gid = wgid / nig, fm = gid * WGM, gsz = (nM - fm) < WGM ? (nM - fm) : WGM;
        u.pm = fm + ((wgid % nig) % gsz); u.pn = (wgid % nig) / gsz; return true;
    }
    __device__ __forceinline__ void a_ready(const Unit&) const {}
    __device__ __forceinline__ void done(const Unit&) const {}
};
struct SplitOrder {
    StaticOrder so; int c;
    __host__ __device__ void init(int N_, int G_, int c_, int K_) { so.init(8192, N_, G_, c_, K_); c = c_; }
    __host__ __device__ bool next(int i, Unit& u) const {
        if (i == 0) return so.next(0, u);
        if (i > 1) return false;
        const int sub = c & 7, tile = c >> 3; u.pm = 32 + (tile >> 3); u.pn = tile & 7;
        const int b0 = ((so.ntk * sub) / 8 + 1) & ~1, b1 = ((so.ntk * (sub + 1)) / 8 + 1) & ~1; u.kt0 = b0; u.nkt = b1 - b0; return true;
    }
    __device__ __forceinline__ void a_ready(const Unit&) const {}
    __device__ __forceinline__ void done(const Unit&) const {}
};

__device__ __forceinline__ void rl_fetch(const float* R, LAS float* RL, const Unit& u, int wid, int lane, int par) {
    if (wid < 4) __builtin_amdgcn_global_load_lds((const unsigned*)(R + u.pm * BM + wid * 64 + lane), (LAS unsigned*)(RL + par * 256 + wid * 64), 4, 0, 0);
}
struct EpiF32 {
    static constexpr bool PERM = false;
    float* C; int ldc; const float* R; LAS float* RL;
    __device__ __forceinline__ void prefetch(const Unit& u, int wid, int lane, int par) const { rl_fetch(R, RL, u, wid, lane, par); }
    __device__ __forceinline__ void operator()(const f32x4 (&acc)[2][2][4][2], const Unit& u, int wr, int wc, int fr, int fq, int par) const {
        const int row0 = u.pm * BM + wr * 64 + fr, col0 = u.pn * BM + wc * 32 + 4 * fq;
        float rr[2][4];
#pragma unroll
        for (int ai = 0; ai < 2; ++ai)
#pragma unroll
            for (int m = 0; m < 4; ++m) rr[ai][m] = RL[par * 256 + wr * 64 + fr + ai * HALF + m * 16];
        __builtin_amdgcn_sched_barrier(0);
#pragma unroll
        for (int ai = 0; ai < 2; ++ai)
#pragma unroll
            for (int m = 0; m < 4; ++m) { float* rowp = C + (size_t)(row0 + ai * HALF + m * 16) * ldc + col0; const float r = rr[ai][m];
#pragma unroll
                for (int bj = 0; bj < 2; ++bj)
#pragma unroll
                    for (int n = 0; n < 2; ++n) *(f32x4*)(rowp + bj * HALF + n * 16) = acc[ai][bj][m][n] * r; }
    }
};
struct EpiResid {
    static constexpr bool PERM = true;
    bf16_t* XB; int ldc; float scale; bf16_t* P; int ntk; float* Y;
    __device__ __forceinline__ void prefetch(const Unit&, int, int, int) const {}
    float* SSP;
    __device__ __forceinline__ void operator()(const f32x4 (&acc)[2][2][4][2], const Unit& u, int wr, int wc, int fr, int fq, int par) const {
        const int row0 = u.pm * BM + wr * 64 + fr, col0 = u.pn * BM + wc * 32 + 8 * fq;
        if (u.nkt != ntk) {
            bf16_t* Pb = P + (size_t)((u.kt0 * 8) / ntk) * (1024 * 2048) + (size_t)(row0 - 8192) * 2048 + col0;
#pragma unroll
            for (int ai = 0; ai < 2; ++ai)
#pragma unroll
                for (int m = 0; m < 4; ++m)
#pragma unroll
                    for (int bj = 0; bj < 2; ++bj) { const f32x4 t0 = acc[ai][bj][m][0], t1 = acc[ai][bj][m][1]; float v[8] = {t0.x, t0.y, t0.z, t0.w, t1.x, t1.y, t1.z, t1.w};
                        *(bf16x8*)(Pb + (size_t)(ai * HALF + m * 16) * 2048 + bj * HALF) = pack8(v); }
            return;
        }
        u32x4 b[2][4][2];
#pragma unroll
        for (int ai = 0; ai < 2; ++ai)
#pragma unroll
            for (int m = 0; m < 4; ++m)
#pragma unroll
                for (int bj = 0; bj < 2; ++bj) b[ai][m][bj] = *(const u32x4*)(XB + (size_t)(row0 + ai * HALF + m * 16) * ldc + col0 + bj * HALF);
#pragma unroll
        for (int ai = 0; ai < 2; ++ai)
#pragma unroll
            for (int m = 0; m < 4; ++m) { float ss = 0.f;
#pragma unroll
                for (int bj = 0; bj < 2; ++bj) { const u32x4 w = b[ai][m][bj]; const f32x4 t0 = acc[ai][bj][m][0], t1 = acc[ai][bj][m][1];
                    float v[8] = {bflo(w.x) + t0.x * scale, bfhi(w.x) + t0.y * scale, bflo(w.y) + t0.z * scale, bfhi(w.y) + t0.w * scale, bflo(w.z) + t1.x * scale, bfhi(w.z) + t1.y * scale, bflo(w.w) + t1.z * scale, bfhi(w.w) + t1.w * scale};
                    if (Y) { float* yp = Y + (size_t)(row0 + ai * HALF + m * 16) * ldc + col0 + bj * HALF; *(f32x4*)yp = (f32x4){v[0], v[1], v[2], v[3]}; *(f32x4*)(yp + 4) = (f32x4){v[4], v[5], v[6], v[7]}; }
                    else { const bf16x8 o8 = pack8(v); *(bf16x8*)(XB + (size_t)(row0 + ai * HALF + m * 16) * ldc + col0 + bj * HALF) = o8;
                        const u32x4 r4 = __builtin_bit_cast(u32x4, o8);
                        ss += (bflo(r4.x) * bflo(r4.x) + bfhi(r4.x) * bfhi(r4.x)) + (bflo(r4.y) * bflo(r4.y) + bfhi(r4.y) * bfhi(r4.y)) + (bflo(r4.z) * bflo(r4.z) + bfhi(r4.z) * bfhi(r4.z)) + (bflo(r4.w) * bflo(r4.w) + bfhi(r4.w) * bfhi(r4.w)); } }
                if (!Y) {
                    { auto r = __builtin_amdgcn_permlane16_swap(__float_as_uint(ss), __float_as_uint(ss), false, false); ss = __uint_as_float(r[0]) + __uint_as_float(r[1]); }
                    { auto r = __builtin_amdgcn_permlane32_swap(__float_as_uint(ss), __float_as_uint(ss), false, false); ss = __uint_as_float(r[0]) + __uint_as_float(r[1]); }
                    if (fq == 0) SSP[(size_t)(row0 + ai * HALF + m * 16) * 32 + u.pn * 4 + wc] = ss; } }
    }
};
struct EpiSwiGLU {
    static constexpr bool PERM = true;
    bf16_t* O; int ldc; const float* R; LAS float* RL;
    __device__ __forceinline__ void prefetch(const Unit& u, int wid, int lane, int par) const { rl_fetch(R, RL, u, wid, lane, par); }
    __device__ __forceinline__ void operator()(const f32x4 (&acc)[2][2][4][2], const Unit& u, int wr, int wc, int fr, int fq, int par) const {
        const int row0 = u.pm * BM + wr * 64 + fr, col0 = u.pn * HALF + wc * 32 + 8 * fq;
        float rr[2][4];
#pragma unroll
        for (int ai = 0; ai < 2; ++ai)
#pragma unroll
            for (int m = 0; m < 4; ++m) rr[ai][m] = RL[par * 256 + wr * 64 + fr + ai * HALF + m * 16];
        __builtin_amdgcn_sched_barrier(0);
#pragma unroll
        for (int ai = 0; ai < 2; ++ai)
#pragma unroll
            for (int m = 0; m < 4; ++m) {
                float v[8]; const float r = rr[ai][m];
                const f32x2 rc = {-1.4426950408889634f * r, -1.4426950408889634f * r}, r2 = {r * r, r * r};
#pragma unroll
                for (int n = 0; n < 2; ++n)
#pragma unroll
                    for (int h = 0; h < 2; ++h) { const f32x2 g2 = {acc[ai][0][m][n][2 * h], acc[ai][0][m][n][2 * h + 1]}, u2 = {acc[ai][1][m][n][2 * h], acc[ai][1][m][n][2 * h + 1]};
                        const f32x2 ex = g2 * rc; const f32x2 d = (f32x2){__builtin_amdgcn_exp2f(ex.x), __builtin_amdgcn_exp2f(ex.y)} + (f32x2){1.0f, 1.0f};
                        const f32x2 o = ((g2 * u2) * r2) * (f32x2){__builtin_amdgcn_rcpf(d.x), __builtin_amdgcn_rcpf(d.y)};
                        v[n * 4 + 2 * h] = o.x; v[n * 4 + 2 * h + 1] = o.y; }
                *(bf16x8*)(O + (size_t)(row0 + ai * HALF + m * 16) * ldc + col0) = pack8(v); }
    }
};
template <int ACT  > struct EpiBf16 {
    static constexpr bool PERM = true;
    bf16_t* O; int ldc; int col_off; const float* cscale; const float* R; LAS float* RL;
    float* SSV;
    __device__ __forceinline__ void prefetch(const Unit& u, int wid, int lane, int par) const { if (R) rl_fetch(R, RL, u, wid, lane, par); }
    __device__ __forceinline__ void operator()(const f32x4 (&acc)[2][2][4][2], const Unit& u, int wr, int wc, int fr, int fq, int par) const {
        const int row0 = u.pm * BM + wr * 64 + fr, col0 = u.pn * BM + wc * 32 + 8 * fq;
        f32x4 sv[2][2];
#pragma unroll
        for (int bj = 0; bj < 2; ++bj)
#pragma unroll
            for (int n = 0; n < 2; ++n) sv[bj][n] = cscale ? *(const f32x4*)(cscale + col0 + bj * HALF + 4 * n) : (f32x4){1.f, 1.f, 1.f, 1.f};
        float rr[2][4];
#pragma unroll
        for (int ai = 0; ai < 2; ++ai)
#pragma unroll
            for (int m = 0; m < 4; ++m) rr[ai][m] = R ? RL[par * 256 + wr * 64 + fr + ai * HALF + m * 16] : 1.f;
        __builtin_amdgcn_sched_barrier(0);
#pragma unroll
        for (int ai = 0; ai < 2; ++ai)
#pragma unroll
            for (int m = 0; m < 4; ++m) { bf16_t* rowp = O + (size_t)(row0 + ai * HALF + m * 16) * ldc + col_off + col0; const float rs = rr[ai][m]; float ss = 0.f;
#pragma unroll
                for (int bj = 0; bj < 2; ++bj) {
                    float v[8];
#pragma unroll
                    for (int n = 0; n < 2; ++n)
#pragma unroll
                        for (int e = 0; e < 4; ++e) { float x = acc[ai][bj][m][n][e] * rs;
                            if (ACT == 1) { const float t = 0.7978845608028654f * (x + 0.044715f * x * x * x);
                                x = x * __builtin_amdgcn_rcpf(1.0f + __builtin_amdgcn_exp2f(-2.8853900817779268f * t)); }
                            else x *= sv[bj][n][e];
                            v[n * 4 + e] = x; }
                    const bf16x8 o8 = pack8(v); *(bf16x8*)(rowp + bj * HALF) = o8;
                    if (ACT == 1) { const u32x4 r4 = __builtin_bit_cast(u32x4, o8);
                        ss += (bflo(r4.x) * bflo(r4.x) + bfhi(r4.x) * bfhi(r4.x)) + (bflo(r4.y) * bflo(r4.y) + bfhi(r4.y) * bfhi(r4.y)) + (bflo(r4.z) * bflo(r4.z) + bfhi(r4.z) * bfhi(r4.z)) + (bflo(r4.w) * bflo(r4.w) + bfhi(r4.w) * bfhi(r4.w)); } }
                if (ACT == 1 && SSV && u.pn >= 8) {
                    { auto r = __builtin_amdgcn_permlane16_swap(__float_as_uint(ss), __float_as_uint(ss), false, false); ss = __uint_as_float(r[0]) + __uint_as_float(r[1]); }
                    { auto r = __builtin_amdgcn_permlane32_swap(__float_as_uint(ss), __float_as_uint(ss), false, false); ss = __uint_as_float(r[0]) + __uint_as_float(r[1]); }
                    if (fq == 0) SSV[(size_t)(row0 + ai * HALF + m * 16) * 32 + (u.pn - 8) * 4 + wc] = ss; } }
    }
};

struct EpiKV {
    static constexpr bool PERM = true;
    bf16_t* O; int ldc; const float* gain; LAS float* xs;
    __device__ __forceinline__ void prefetch(const Unit&, int, int, int) const {}
    __device__ __forceinline__ void operator()(const f32x4 (&acc)[2][2][4][2], const Unit& u, int wr, int wc, int fr, int fq, int par) const {
        const int row0 = u.pm * BM + wr * 64 + fr, col0 = u.pn * BM + wc * 32 + 8 * fq;
        const f32x4 g0 = *(const f32x4*)(gain + wc * 32 + 8 * fq), g1 = *(const f32x4*)(gain + wc * 32 + 8 * fq + 4);
#pragma unroll
        for (int ai = 0; ai < 2; ++ai)
#pragma unroll
            for (int m = 0; m < 4; ++m) { float ss = 0.f;
#pragma unroll
                for (int n = 0; n < 2; ++n)
#pragma unroll
                    for (int e = 0; e < 4; ++e) ss += acc[ai][0][m][n][e] * acc[ai][0][m][n][e];
                { auto r = __builtin_amdgcn_permlane16_swap(__float_as_uint(ss), __float_as_uint(ss), false, false); ss = __uint_as_float(r[0]) + __uint_as_float(r[1]); }
                { auto r = __builtin_amdgcn_permlane32_swap(__float_as_uint(ss), __float_as_uint(ss), false, false); ss = __uint_as_float(r[0]) + __uint_as_float(r[1]); }
                if (fq == 0) xs[(ai * HALF + wr * 64 + m * 16 + fr) * 4 + wc] = ss; }
        asm volatile("s_waitcnt lgkmcnt(0)" ::: "memory"); __builtin_amdgcn_s_barrier(); asm volatile("" ::: "memory");
#pragma unroll
        for (int ai = 0; ai < 2; ++ai)
#pragma unroll
            for (int m = 0; m < 4; ++m) { const f32x4 t = *(const LAS f32x4*)(xs + (ai * HALF + wr * 64 + m * 16 + fr) * 4);
                const float r = 1.0f / sqrtf(((t.x + t.y) + (t.z + t.w)) * (1.f / 128.f) + 1e-6f);
                bf16_t* rowp = O + (size_t)(row0 + ai * HALF + m * 16) * ldc + col0;
                { float v[8]; const f32x4 a0 = acc[ai][0][m][0], a1 = acc[ai][0][m][1];
                  v[0] = a0.x * r * g0.x; v[1] = a0.y * r * g0.y; v[2] = a0.z * r * g0.z; v[3] = a0.w * r * g0.w; v[4] = a1.x * r * g1.x; v[5] = a1.y * r * g1.y; v[6] = a1.z * r * g1.z; v[7] = a1.w * r * g1.w;
                  *(bf16x8*)rowp = pack8(v); }
                { float v[8]; const f32x4 a0 = acc[ai][1][m][0], a1 = acc[ai][1][m][1];
                  v[0] = a0.x; v[1] = a0.y; v[2] = a0.z; v[3] = a0.w; v[4] = a1.x; v[5] = a1.y; v[6] = a1.z; v[7] = a1.w;
                  *(bf16x8*)(rowp + HALF) = pack8(v); } }
    }
};

template <class Epi, class Sched, bool ALIGN_EPI = true>
__device__ __forceinline__ void gemm_phase(LAS unsigned char* lds, const Gemm g, const Sched& S, const Epi& E, int tid_in, const Gate gate = Gate{nullptr, 0u, nullptr, nullptr, -1, 32}) {
    int tid_ = tid_in; asm volatile("" : "+v"(tid_));
    const int tid = tid_, wid = __builtin_amdgcn_readfirstlane(tid >> 6), lane = tid & 63, wr = wid >> 2, wc = wid & 3, fr = lane & 15, fq = lane >> 4;
    unsigned voffA[2], voffB[2];
#pragma unroll
    for (int i = 0; i < 2; ++i) { int R, C; stage_rc(tid * 16 + i * 8192, R, C); const int Rb = Epi::PERM ? ((R & ~31) + perm32(R & 31)) : R;
        voffA[i] = (unsigned)(R * g.lda + C) * 2u; voffB[i] = (unsigned)(Rb * g.ldb + C) * 2u; }
    const size_t kstep = (size_t)(BK * 2);
    const size_t hsA = (size_t)HALF * g.lda * 2, hsB = (size_t)HALF * g.ldb * 2;
    const size_t tsA = 2 * hsA, tsB = 2 * hsB;
    const unsigned ldsw = (unsigned)wid * 1024u;
    const int aoff = lds_byte(wr * 64 + fr, fq * 8), boff = lds_byte(wc * 32 + fr, fq * 8);
#define PG8_SA(b, h) (((b) * 2 + (h)) * HTB)
#define PG8_SB(b, h) ((4 + (b) * 2 + (h)) * HTB)
#define PG8_STAGE(bufoff, gbase, voff) do { _Pragma("unroll") for (int _i = 0; _i < 2; ++_i) \
        __builtin_amdgcn_global_load_lds((const unsigned*)((const char*)(gbase) + (voff)[_i]), (LAS unsigned*)(lds + (bufoff) + ldsw + _i * 8192), 16, 0, 0); } while (0)
#define PG8_LDA(dst, b, h) do { _Pragma("unroll") for (int m = 0; m < 4; ++m) _Pragma("unroll") for (int k = 0; k < 2; ++k) dst[m][k] = *(const LAS bf16x8*)(lds + PG8_SA(b, h) + aoff + m * 2048 + k * 1024); } while (0)
#define PG8_LDB(dst, b, h) do { _Pragma("unroll") for (int n = 0; n < 2; ++n) _Pragma("unroll") for (int k = 0; k < 2; ++k) dst[n][k] = *(const LAS bf16x8*)(lds + PG8_SB(b, h) + boff + n * 2048 + k * 1024); } while (0)
#define PG8_MMA(ai, bj, At, Bt) do { __builtin_amdgcn_s_setprio(1); _Pragma("unroll") for (int m = 0; m < 4; ++m) _Pragma("unroll") for (int n = 0; n < 2; ++n) _Pragma("unroll") for (int k = 0; k < 2; ++k) \
        acc[ai][bj][m][n] = __builtin_amdgcn_mfma_f32_16x16x32_bf16(Bt[n][k], At[m][k], acc[ai][bj][m][n], 0, 0, 0); __builtin_amdgcn_s_setprio(0); } while (0)
#define PG8_WAIT_V(n) asm volatile("s_waitcnt vmcnt(" #n ")" ::: "memory")
#define PG8_WAIT_L(n) asm volatile("s_waitcnt lgkmcnt(" #n ")" ::: "memory")
#define PG8_BAR __builtin_amdgcn_s_barrier()
#define PG8_SCHED __builtin_amdgcn_sched_barrier(0)
    Unit cur, nxt; int ui = 0;
    if (!S.next(0, cur)) return;
    bool open = (gate.evt == nullptr);
    if (!open && cur.pm >= gate.pm0) { if (tid == 0) evt_wait_one(gate); __syncthreads(); open = true; }
    if (open) E.prefetch(cur, wid, lane, 0);
    f32x4 acc[2][2][4][2];
#pragma unroll
    for (int a = 0; a < 2; ++a)
#pragma unroll
        for (int b = 0; b < 2; ++b)
#pragma unroll
            for (int m = 0; m < 4; ++m)
#pragma unroll
                for (int n = 0; n < 2; ++n) acc[a][b][m][n] = (f32x4){0.f, 0.f, 0.f, 0.f};
    bf16x8 At[4][2], B0[2][2], B1[2][2];
    const char* cA = (const char*)g.A + (size_t)cur.pm * tsA + (size_t)cur.pn * g.apn + (size_t)cur.kt0 * kstep; const char* cB = (const char*)g.Bt + (size_t)cur.pn * tsB + (size_t)cur.kt0 * kstep;
    S.a_ready(cur);
    PG8_STAGE(PG8_SB(0, 0), cB, voffB); PG8_STAGE(PG8_SB(0, 1), cB + hsB, voffB); PG8_STAGE(PG8_SA(0, 0), cA, voffA); PG8_STAGE(PG8_SA(0, 1), cA + hsA, voffA);
    if (wr == 1) PG8_BAR;
    PG8_WAIT_V(2); PG8_BAR;
    PG8_STAGE(PG8_SB(1, 0), cB + kstep, voffB); PG8_STAGE(PG8_SA(1, 0), cA + kstep, voffA); PG8_STAGE(PG8_SB(1, 1), cB + hsB + kstep, voffB);
    PG8_WAIT_V(6); PG8_BAR;
    for (;;) {
        const bool has_next = S.next(ui + 1, nxt);
        const char* nA = has_next ? (const char*)g.A + (size_t)nxt.pm * tsA + (size_t)nxt.pn * g.apn + (size_t)nxt.kt0 * kstep : cA; const char* nB = has_next ? (const char*)g.Bt + (size_t)nxt.pn * tsB + (size_t)nxt.kt0 * kstep : cB;
        const int nt = cur.nkt;
        for (int t = 0; t < nt; t += 2) {
            const bool last = (t == nt - 2);
            const char* a1 = cA + (size_t)(t + 1) * kstep;
            const char* a2 = last ? nA : cA + (size_t)(t + 2) * kstep; const char* b2 = last ? nB : cB + (size_t)(t + 2) * kstep;
            const char* a3 = a2 + kstep; const char* b3 = b2 + kstep;
            if (last && has_next) S.a_ready(nxt);
            const bool gate_now = !open && (gate.tg < 0 ? last : t == gate.tg);
            if (gate_now && tid == 0) evt_wait_one(gate);
            PG8_LDB(B0, 0, 0); PG8_LDB(B1, 0, 1); PG8_SCHED; PG8_LDA(At, 0, 0); PG8_STAGE(PG8_SA(1, 1), a1 + hsA, voffA);
            PG8_WAIT_V(8); PG8_WAIT_L(0); PG8_BAR; PG8_MMA(0, 0, At, B0); PG8_MMA(0, 1, At, B1); PG8_BAR; PG8_SCHED;
            if (gate_now) { E.prefetch(cur, wid, lane, ui & 1); open = true; }
            PG8_LDA(At, 0, 1); PG8_STAGE(PG8_SB(0, 0), b2, voffB); PG8_STAGE(PG8_SB(0, 1), b2 + hsB, voffB); PG8_STAGE(PG8_SA(0, 0), a2, voffA);
            PG8_WAIT_V(8); PG8_WAIT_L(0); PG8_BAR; PG8_MMA(1, 0, At, B0); PG8_MMA(1, 1, At, B1); PG8_BAR; PG8_SCHED;
            PG8_LDB(B0, 1, 0); PG8_LDB(B1, 1, 1); PG8_SCHED; PG8_LDA(At, 1, 0); PG8_STAGE(PG8_SA(0, 1), a2 + hsA, voffA);
            PG8_WAIT_V(8); PG8_WAIT_L(0); PG8_BAR; PG8_MMA(0, 0, At, B0); PG8_MMA(0, 1, At, B1); PG8_BAR; PG8_SCHED;
            PG8_LDA(At, 1, 1); PG8_STAGE(PG8_SB(1, 0), b3, voffB); PG8_STAGE(PG8_SB(1, 1), b3 + hsB, voffB); PG8_STAGE(PG8_SA(1, 0), a3, voffA);
            PG8_WAIT_V(8); PG8_WAIT_L(0); PG8_BAR; PG8_MMA(1, 0, At, B0); PG8_MMA(1, 1, At, B1); PG8_BAR; PG8_SCHED;
        }
        if constexpr (ALIGN_EPI) { if (wr == 0) PG8_BAR; }
        E(acc, cur, wr, wc, fr, fq, ui & 1); S.done(cur);
        if (!has_next) break;
#pragma unroll
        for (int a = 0; a < 2; ++a)
#pragma unroll
            for (int b = 0; b < 2; ++b)
#pragma unroll
                for (int m = 0; m < 4; ++m)
#pragma unroll
                    for (int n = 0; n < 2; ++n) acc[a][b][m][n] = (f32x4){0.f, 0.f, 0.f, 0.f};
        cur = nxt; cA = nA; cB = nB; ++ui;
        E.prefetch(cur, wid, lane, ui & 1);
        if constexpr (ALIGN_EPI) { if (wr == 1) PG8_BAR; }
    }
    PG8_WAIT_V(0);
    if constexpr (!ALIGN_EPI) { if (wr == 0) PG8_BAR; }
    PG8_BAR;
#undef PG8_SA
#undef PG8_SB
#undef PG8_STAGE
#undef PG8_LDA
#undef PG8_LDB
#undef PG8_MMA
#undef PG8_WAIT_V
#undef PG8_WAIT_L
#undef PG8_BAR
#undef PG8_SCHED
}
}

#define XB_TMO      128
#define XB_XCNT(j)  (256  + 64 * (j))
#define XB_XSUB(j)  (1280 + 64 * (j))
#define XB_XGEN(j)  (2304 + 64 * (j))
#define XB_TOP      3328
#define XB_TOPGEN   3392
#define XCD_BAR_WORDS 3456
#define XB_SPIN_CAP (1u << 18)
__device__ __forceinline__ unsigned xb_ld(unsigned* p)              { return __hip_atomic_load(p, __ATOMIC_RELAXED, __HIP_MEMORY_SCOPE_AGENT); }
__device__ __forceinline__ unsigned xb_add(unsigned* p, unsigned v) { return __hip_atomic_fetch_add(p, v, __ATOMIC_RELAXED, __HIP_MEMORY_SCOPE_AGENT); }
__device__ __forceinline__ unsigned xb_xcc_id() { return (unsigned)__builtin_amdgcn_s_getreg((3 << 11) | 20) & 0xFu; }
#define XB_SPIN(cond, bar) do { unsigned _sp = 0; while (cond) { __builtin_amdgcn_s_sleep(1); \
    if ((++_sp & 255u) == 0u) { if (xb_ld(&(bar)[XB_TMO])) break; if (_sp > XB_SPIN_CAP) { atomicAdd(&(bar)[XB_TMO], 1u); break; } } } } while (0)
struct XcdBarrier { unsigned* bar; unsigned x; volatile LAS unsigned* st; };
__device__ __forceinline__ XcdBarrier xcd_barrier_post(unsigned* bar, volatile LAS unsigned* st) {
    XcdBarrier b; b.bar = bar; b.x = xb_xcc_id(); b.st = st;
    if (threadIdx.x == 0) (void)xb_add(&bar[XB_XCNT(b.x)], 1u);
    return b;
}
__device__ __forceinline__ void xcd_barrier_complete(unsigned* bar, unsigned x, unsigned& nloc, unsigned& nx) {
    const unsigned G = gridDim.x * gridDim.y * gridDim.z;
    unsigned sum, cnt, mine, sp = 0u;
    for (;;) {
        sum = 0u; cnt = 0u; mine = 0u;
#pragma unroll
        for (unsigned j = 0; j < 16; ++j) { const unsigned c = xb_ld(&bar[XB_XCNT(j)]); sum += c; cnt += (c > 0u) ? 1u : 0u; mine = (j == x) ? c : mine; }
        if (sum == G) break;
        __builtin_amdgcn_s_sleep(1);
        if ((++sp & 255u) == 0u) { if (xb_ld(&bar[XB_TMO])) break; if (sp > XB_SPIN_CAP) { atomicAdd(&bar[XB_TMO], 1u); break; } }
    }
    nloc = mine > 0u ? mine : 1u; nx = cnt > 0u ? cnt : 1u;
}
__device__ __forceinline__ void xcd_barrier(const XcdBarrier& b) {
    asm volatile("s_waitcnt vmcnt(0)" ::: "memory");
    __syncthreads();
    if (threadIdx.x == 0) {
        unsigned* bar = b.bar;
        __builtin_amdgcn_s_waitcnt(0);
        unsigned nloc = b.st[0], nx = b.st[1];
        if (nloc == 0u) { xcd_barrier_complete(bar, b.x, nloc, nx); b.st[0] = nloc; b.st[1] = nx; }
        const unsigned old = xb_add(&bar[XB_XSUB(b.x)], 1u);
        const unsigned gen = old / nloc;
        if (old + 1u == (gen + 1u) * nloc) {
            __builtin_amdgcn_fence(__ATOMIC_RELEASE, "agent");
            asm volatile("s_waitcnt vmcnt(0)" ::: "memory");
            const unsigned og = xb_add(&bar[XB_TOP], 1u);
            const unsigned tg = og / nx;
            if (og + 1u == (tg + 1u) * nx) xb_add(&bar[XB_TOPGEN], 1u);
            else XB_SPIN(xb_ld(&bar[XB_TOPGEN]) == tg, bar);
            __builtin_amdgcn_fence(__ATOMIC_ACQUIRE, "agent");
            xb_add(&bar[XB_XGEN(b.x)], 1u);
            asm volatile("s_waitcnt vmcnt(0)" ::: "memory");
        } else {
            XB_SPIN(xb_ld(&bar[XB_XGEN(b.x)]) == gen, bar);
            __builtin_amdgcn_fence(__ATOMIC_ACQUIRE, "agent");
            asm volatile("s_waitcnt vmcnt(0)" ::: "memory");
        }
    }
    __syncthreads();
}

struct Args { const float* in[31]; float* out; unsigned char* ws; int lo, hi; int plan[48]; };
#define INP(i) ((const float*)(const GAS float*)a.in[({ int _i = (i); asm volatile("" : "+s"(_i)); _i; })])
struct Frame { LAS unsigned char* lds; int tid, lane, wave, vcu, G, gw, NGW; };
__device__ __forceinline__ Frame make_frame(LAS unsigned char* lds, int wave0) {
    Frame F; int ln; asm volatile("v_mbcnt_lo_u32_b32 %0, -1, 0\n\tv_mbcnt_hi_u32_b32 %0, -1, %0" : "=v"(ln)); int bx = blockIdx.x;        asm volatile("" : "+s"(bx));
    const int t = wave0 * 64 + ln;
    F.lds = lds; F.tid = t; F.lane = ln; F.wave = wave0;
    F.G = gridDim.x; F.vcu = (F.G % 8 == 0) ? (bx % 8) * (F.G / 8) + bx / 8 : bx;
    F.gw = F.vcu * 8 + F.wave; F.NGW = F.G * 8; return F;
}

__device__ __forceinline__ void tr_load(f32x4 (&v)[16], const float* W, int N, int item, int lane) {
    const int nblk = N / 64, kb = item / nblk, nb = item % nblk, k0 = 64 * kb, n0 = 64 * nb;
    const int lr = lane >> 4, lc = (lane & 15) * 4;
#pragma unroll
    for (int i = 0; i < 16; ++i) v[i] = __builtin_nontemporal_load((const f32x4*)(W + (size_t)(k0 + 4 * i + lr) * N + n0 + lc));
}
__device__ __forceinline__ void tr_to_lds(const f32x4 (&v)[16], LAS float* scr, int lane) {
    const int lr = lane >> 4, lc = (lane & 15) * 4;
#pragma unroll
    for (int i = 0; i < 16; ++i) { LAS float* d = scr + (4 * i + lr) * 65 + lc; d[0] = v[i].x; d[1] = v[i].y; d[2] = v[i].z; d[3] = v[i].w; }
}
template <class RowMap>
__device__ __forceinline__ void tr_emit(int K, int N, bf16_t* WT, const RowMap& rm, LAS float* scr, int item, int lane, const float* gk) {
    const int nblk = N / 64, kb = item / nblk, nb = item % nblk, k0 = 64 * kb, n0 = 64 * nb;
    LDS_WAIT(); asm volatile("" ::: "memory");
    const int c = lane & 7;
    f32x4 ga = {1.f, 1.f, 1.f, 1.f}, gb = {1.f, 1.f, 1.f, 1.f};
    if (gk) { ga = *(const f32x4*)(gk + k0 + 8 * c); gb = *(const f32x4*)(gk + k0 + 8 * c + 4); }
#pragma unroll
    for (int j = 0; j < 8; ++j) { const int n = (lane >> 3) + 8 * j; const LAS float* s = scr + (8 * c) * 65 + n;
        u32x4 o; o.x = cvt_pk_bf16(s[0 * 65] * ga.x, s[1 * 65] * ga.y); o.y = cvt_pk_bf16(s[2 * 65] * ga.z, s[3 * 65] * ga.w); o.z = cvt_pk_bf16(s[4 * 65] * gb.x, s[5 * 65] * gb.y); o.w = cvt_pk_bf16(s[6 * 65] * gb.z, s[7 * 65] * gb.w);
        *(u32x4*)(WT + (size_t)rm(n0 + n) * K + k0 + 8 * c) = o; }
    LDS_WAIT(); asm volatile("" ::: "memory");
}
struct RmId { int off; __device__ __forceinline__ int operator()(int n) const { return off + n; } };
struct RmAny { int mode, off; __device__ __forceinline__ int operator()(int n) const { return mode ? (n >> 7) * 256 + off + (n & 127) : off + n; } };
struct RmGU { int up; __device__ __forceinline__ int operator()(int n) const { return (n >> 7) * 256 + up * 128 + (n & 127); } };
__device__ __forceinline__ f32x4 bf4(u32x2 w) { return (f32x4){bflo(w.x), bfhi(w.x), bflo(w.y), bfhi(w.y)}; }
__device__ __forceinline__ u32x2 pk4(f32x4 v) { u32x2 w; w.x = cvt_pk_bf16(v.x, v.y); w.y = cvt_pk_bf16(v.z, v.w); return w; }
__device__ __forceinline__ void stat_pass(const Frame& F, bf16_t* xb, float* R, const bf16_t* P, float fix, const float* src0, const float* src1, const float* SSP) {
    if (!src0) {
        for (int row = F.vcu * NTHR + F.tid; row < MP; row += F.G * NTHR) { const f32x4* sp = (const f32x4*)(SSP + (size_t)row * 32); f32x4 t = sp[0];
#pragma unroll
            for (int k = 1; k < 8; ++k) t += sp[k];
            R[row] = rsq(((t.x + t.y) + (t.z + t.w)) * (1.f / DM) + EPS); }
    }
    else for (int row = F.gw; row < MP; row += 2 * F.NGW) {
        const int row2 = row + F.NGW; const bool two = row2 < MP;
        f32x4 v[2][8];
#pragma unroll
        for (int q = 0; q < 2; ++q) { const int r = q ? row2 : row; if (q == 0 || two) {
            if (src0) { const f32x4* sr = (const f32x4*)(src0 + (size_t)r * DM) + F.lane;
#pragma unroll
                for (int j = 0; j < 8; ++j) v[q][j] = sr[64 * j]; }
            else { const u32x2* sr = (const u32x2*)(xb + (size_t)r * DM) + F.lane;
#pragma unroll
                for (int j = 0; j < 8; ++j) v[q][j] = bf4(sr[64 * j]); } } }
#pragma unroll
        for (int q = 0; q < 2; ++q) { const int r = q ? row2 : row; if (q == 0 || two) {
            float s = 0.f;
            if (src0) { u32x2* xr = (u32x2*)(xb + (size_t)r * DM) + F.lane;
#pragma unroll
                for (int j = 0; j < 8; ++j) { const u32x2 w = pk4(v[q][j]); xr[64 * j] = w; v[q][j] = bf4(w); } }
#pragma unroll
            for (int j = 0; j < 8; ++j) s += (v[q][j].x * v[q][j].x + v[q][j].y * v[q][j].y) + (v[q][j].z * v[q][j].z + v[q][j].w * v[q][j].w);
            const float rr = rsq(wave_sum(s) * (1.f / DM) + EPS);
            if (F.lane == 0) R[r] = rr; } }
    }
    for (int row = MP + F.gw; row < M; row += F.NGW) {
        u32x2* xr = (u32x2*)(xb + (size_t)row * DM) + F.lane;
        f32x4 v[8]; float s = 0.f;
        if (src0) { const f32x4* sr = (const f32x4*)(src1 + (size_t)(row - MP) * DM) + F.lane;
#pragma unroll
            for (int j = 0; j < 8; ++j) v[j] = sr[64 * j]; }
        else {
#pragma unroll
            for (int j = 0; j < 8; ++j) v[j] = bf4(xr[64 * j]); }
        if (fix != 0.f) {
            const u32x2* pr = (const u32x2*)(P + (size_t)(row - MP) * DM) + F.lane;
#pragma unroll
            for (int j = 0; j < 8; ++j) { f32x4 t = {0.f, 0.f, 0.f, 0.f};
#pragma unroll
                for (int sl = 0; sl < 8; ++sl) t += bf4(pr[(size_t)sl * (1024 * 2048 / 4) + 64 * j]);
                v[j] += t * fix; }
        }
        if (src0 || fix != 0.f) {
#pragma unroll
            for (int j = 0; j < 8; ++j) { const u32x2 w = pk4(v[j]); xr[64 * j] = w; v[j] = bf4(w); }
        }
#pragma unroll
        for (int j = 0; j < 8; ++j) s += (v[j].x * v[j].x + v[j].y * v[j].y) + (v[j].z * v[j].z + v[j].w * v[j].w);
        const float rr = rsq(wave_sum(s) * (1.f / DM) + EPS);
        if (F.lane == 0) R[row] = rr;
    }
}

__device__ __forceinline__ void stat_pass2(const Frame& F, bf16_t* xb, float* R, const bf16_t* P, float fix, const float* SSP) {
    if (F.tid < 256) { const int row = 32 * F.vcu + (F.tid >> 3); const f32x4 t = *(const f32x4*)(SSP + (size_t)row * 32 + 4 * (F.tid & 7));
        float s = (t.x + t.y) + (t.z + t.w); s += dpp_f<0xB1>(s); s += dpp_f<0x4E>(s); s += dpp_f<0x141>(s);
        if ((F.tid & 7) == 0) R[row] = rsq(s * (1.f / DM) + EPS); }
    const int half = F.wave >> 2, row = MP + 4 * F.vcu + (F.wave & 3);
    u32x4* xr = (u32x4*)(xb + (size_t)row * DM + half * 1024) + F.lane;
    const u32x4* pr = (const u32x4*)(P + (size_t)(row - MP) * DM + half * 1024) + F.lane;
    u32x4 w[2], q[8][2];
#pragma unroll
    for (int j = 0; j < 2; ++j) w[j] = xr[64 * j];
#pragma unroll
    for (int sl = 0; sl < 8; ++sl)
#pragma unroll
        for (int j = 0; j < 2; ++j) q[sl][j] = pr[(size_t)sl * (1024 * 2048 / 8) + 64 * j];
    float s = 0.f;
#pragma unroll
    for (int j = 0; j < 2; ++j) {
        f32x4 t0 = {0.f, 0.f, 0.f, 0.f}, t1 = {0.f, 0.f, 0.f, 0.f};
#pragma unroll
        for (int sl = 0; sl < 8; ++sl) { t0 += bf4((u32x2){q[sl][j].x, q[sl][j].y}); t1 += bf4((u32x2){q[sl][j].z, q[sl][j].w}); }
        const f32x4 v0 = bf4((u32x2){w[j].x, w[j].y}) + t0 * fix, v1 = bf4((u32x2){w[j].z, w[j].w}) + t1 * fix;
        const u32x2 o0 = pk4(v0), o1 = pk4(v1);
        xr[64 * j] = (u32x4){o0.x, o0.y, o1.x, o1.y};
        const f32x4 r0 = bf4(o0), r1 = bf4(o1);
        s += (r0.x * r0.x + r0.y * r0.y) + (r0.z * r0.z + r0.w * r0.w) + (r1.x * r1.x + r1.y * r1.y) + (r1.z * r1.z + r1.w * r1.w);
    }
    s = wave_sum(s);
    LAS float* sc = (LAS float*)(F.lds + AUX_OFF + 6144);
    if (F.lane == 0) sc[F.wave] = s;
    __syncthreads();
    if (F.wave < 4 && F.lane == 0) R[row] = rsq((sc[F.wave] + sc[F.wave + 4]) * (1.f / DM) + EPS);
}

template <int W> __device__ __forceinline__ void pool16(const float* zc, const float* hs, bf16_t* pc, int l0, bool prm) {
    float u[W + 15];
#pragma unroll
    for (int t = 0; t < W + 15; ++t) { const int l = l0 - (W - 1) + t; u[t] = l >= 0 ? zc[(size_t)l * EVINP] : (prm ? 0.f : hs[(size_t)(15 + l) * POOLD]); }
    float sum = 0.f;
#pragma unroll
    for (int t = 0; t < W - 1; ++t) sum += u[t];
#pragma unroll
    for (int i = 0; i < 16; ++i) { const float ul = u[W - 1 + i]; sum += ul; const int l = l0 + i;
        const float cnt = prm ? (float)(l + 1 < W ? l + 1 : W) : (float)W;
        pc[(size_t)l * POOLD] = f2bf(sum / cnt - ul); sum -= u[i]; }
}

__device__ __forceinline__ int crow(int r, int hi) { return (r & 3) + 8 * (r >> 2) + 4 * hi; }
__device__ __forceinline__ int v_st(int k, int c) { const int kk = (k & ~0xC) | ((k & 4) << 1) | ((k & 8) >> 1); return ((kk >> 3) * 4 + (c >> 5)) * 512 + ((kk & 7) * 32 + (c & 31)) * 2; }
__device__ __forceinline__ int v_rd_base(int lane) { return ((lane & 3) << 3) | (((lane >> 2) & 3) << 6) | (((lane >> 4) & 1) << 5) | (((lane >> 5) & 1) << 8); }
constexpr int v_rd_off(int d0, int ks, int half) { return d0 * 512 + ks * 4096 + half * 2048; }
template <int OFF> __device__ __forceinline__ s16x4 tr_read(int vb) {
    s16x4 r; asm volatile("ds_read_b64_tr_b16 %0, %1 offset:%2" : "=&v"(r) : "v"(vb), "i"(OFF) : "memory"); return r;
}
template <int D0> __device__ __forceinline__ void pv_one32(f32x16& od, int vb, bf16x8 pa0, bf16x8 pa1) {
    const s16x4 l0 = tr_read<v_rd_off(D0, 0, 0)>(vb), h0 = tr_read<v_rd_off(D0, 0, 1)>(vb), l1 = tr_read<v_rd_off(D0, 1, 0)>(vb), h1 = tr_read<v_rd_off(D0, 1, 1)>(vb);
    asm volatile("s_waitcnt lgkmcnt(0)" ::: "memory"); SBAR();
#define PK(L, H) (bf16x8){L[0], L[1], L[2], L[3], H[0], H[1], H[2], H[3]}
    od = __builtin_amdgcn_mfma_f32_32x32x16_bf16(pa0, PK(l0, h0), od, 0, 0, 0);
    od = __builtin_amdgcn_mfma_f32_32x32x16_bf16(pa1, PK(l1, h1), od, 0, 0, 0);
#undef PK
}
__device__ __forceinline__ void pv32(f32x16* o, int vb, bf16x8 pa0, bf16x8 pa1) {
    const s16x4 a0 = tr_read<v_rd_off(0, 0, 0)>(vb), a1 = tr_read<v_rd_off(0, 0, 1)>(vb), a2 = tr_read<v_rd_off(0, 1, 0)>(vb), a3 = tr_read<v_rd_off(0, 1, 1)>(vb);
    const s16x4 b0 = tr_read<v_rd_off(1, 0, 0)>(vb), b1 = tr_read<v_rd_off(1, 0, 1)>(vb), b2 = tr_read<v_rd_off(1, 1, 0)>(vb), b3 = tr_read<v_rd_off(1, 1, 1)>(vb);
    const s16x4 c0 = tr_read<v_rd_off(2, 0, 0)>(vb), c1 = tr_read<v_rd_off(2, 0, 1)>(vb), c2 = tr_read<v_rd_off(2, 1, 0)>(vb), c3 = tr_read<v_rd_off(2, 1, 1)>(vb);
    const s16x4 d0 = tr_read<v_rd_off(3, 0, 0)>(vb), d1 = tr_read<v_rd_off(3, 0, 1)>(vb), d2 = tr_read<v_rd_off(3, 1, 0)>(vb), d3 = tr_read<v_rd_off(3, 1, 1)>(vb);
    asm volatile("s_waitcnt lgkmcnt(0)" ::: "memory"); SBAR();
#define PK(L, H) (bf16x8){L[0], L[1], L[2], L[3], H[0], H[1], H[2], H[3]}
    o[0] = __builtin_amdgcn_mfma_f32_32x32x16_bf16(pa0, PK(a0, a1), o[0], 0, 0, 0); o[1] = __builtin_amdgcn_mfma_f32_32x32x16_bf16(pa0, PK(b0, b1), o[1], 0, 0, 0);
    o[2] = __builtin_amdgcn_mfma_f32_32x32x16_bf16(pa0, PK(c0, c1), o[2], 0, 0, 0); o[3] = __builtin_amdgcn_mfma_f32_32x32x16_bf16(pa0, PK(d0, d1), o[3], 0, 0, 0);
    o[0] = __builtin_amdgcn_mfma_f32_32x32x16_bf16(pa1, PK(a2, a3), o[0], 0, 0, 0); o[1] = __builtin_amdgcn_mfma_f32_32x32x16_bf16(pa1, PK(b2, b3), o[1], 0, 0, 0);
    o[2] = __builtin_amdgcn_mfma_f32_32x32x16_bf16(pa1, PK(c2, c3), o[2], 0, 0, 0); o[3] = __builtin_amdgcn_mfma_f32_32x32x16_bf16(pa1, PK(d2, d3), o[3], 0, 0, 0);
#undef PK
}
struct VFrags { s16x4 f[16]; };
__device__ __forceinline__ void pv_load(VFrags& V, int vb) {
    V.f[0] = tr_read<v_rd_off(0, 0, 0)>(vb); V.f[1] = tr_read<v_rd_off(0, 0, 1)>(vb); V.f[2] = tr_read<v_rd_off(0, 1, 0)>(vb); V.f[3] = tr_read<v_rd_off(0, 1, 1)>(vb);
    V.f[4] = tr_read<v_rd_off(1, 0, 0)>(vb); V.f[5] = tr_read<v_rd_off(1, 0, 1)>(vb); V.f[6] = tr_read<v_rd_off(1, 1, 0)>(vb); V.f[7] = tr_read<v_rd_off(1, 1, 1)>(vb);
    V.f[8] = tr_read<v_rd_off(2, 0, 0)>(vb); V.f[9] = tr_read<v_rd_off(2, 0, 1)>(vb); V.f[10] = tr_read<v_rd_off(2, 1, 0)>(vb); V.f[11] = tr_read<v_rd_off(2, 1, 1)>(vb);
    V.f[12] = tr_read<v_rd_off(3, 0, 0)>(vb); V.f[13] = tr_read<v_rd_off(3, 0, 1)>(vb); V.f[14] = tr_read<v_rd_off(3, 1, 0)>(vb); V.f[15] = tr_read<v_rd_off(3, 1, 1)>(vb);
}
__device__ __forceinline__ void pv_mma(f32x16* o, const VFrags& V, bf16x8 pa0, bf16x8 pa1) {
#define PK(L, H) (bf16x8){L[0], L[1], L[2], L[3], H[0], H[1], H[2], H[3]}
#pragma unroll
    for (int d = 0; d < 4; ++d) o[d] = __builtin_amdgcn_mfma_f32_32x32x16_bf16(pa0, PK(V.f[4 * d], V.f[4 * d + 1]), o[d], 0, 0, 0);
#pragma unroll
    for (int d = 0; d < 4; ++d) o[d] = __builtin_amdgcn_mfma_f32_32x32x16_bf16(pa1, PK(V.f[4 * d + 2], V.f[4 * d + 3]), o[d], 0, 0, 0);
#undef PK
}
#define VT_LOAD(vr, src, ld) do { _Pragma("unroll") for (int _it = 0; _it < 8; ++_it) vr[_it] = *(const bf16x8*)((src) + (size_t)(4 * _it + (lane >> 4)) * (ld) + (lane & 15) * 8); } while (0)
#define VT_WRITE(vl, vr) do { _Pragma("unroll") for (int _it = 0; _it < 8; ++_it) *(LAS bf16x8*)((vl) + v_st(4 * _it + (lane >> 4), (lane & 15) * 8)) = vr[_it]; } while (0)

__device__ __forceinline__ void load_q_frags(bf16x8 (&qr)[12], const bf16_t* Q, int row, int h, int hi, const float* tab, const float* gqn, const float* gqp) {
    const bf16_t* qp = Q + (size_t)row * 1536 + h * QKH + 8 * hi;
        bf16x8 raw[12];
#pragma unroll
        for (int d0 = 0; d0 < 12; ++d0) raw[d0] = *(const bf16x8*)(qp + 16 * d0);
        float ssn = 0.f, ssp = 0.f;
#pragma unroll
        for (int d0 = 0; d0 < 12; ++d0)
#pragma unroll
            for (int j = 0; j < 8; ++j) { const float f = bf1(raw[d0][j]); if (d0 < 8) ssn += f * f; else ssp += f * f; }
        ssn = xor32_sum(ssn); ssp = xor32_sum(ssp);
        const float rn = rsq(ssn * (1.f / NOPE) + EPS), rp = rsq(ssp * (1.f / ROPE) + EPS);
#pragma unroll
        for (int d0 = 0; d0 < 8; ++d0) { float v[8]; const float* gp = gqn + 16 * d0 + 8 * hi;
#pragma unroll
            for (int j = 0; j < 8; ++j) v[j] = bf1(raw[d0][j]) * rn * gp[j];
            qr[d0] = pack8(v); }
#pragma unroll
        for (int d0 = 8; d0 < 10; ++d0) { float v1[8], v2[8]; const int i0 = 16 * (d0 - 8) + 8 * hi; const float* tp = tab + (size_t)row * 64 + i0;
#pragma unroll
            for (int j = 0; j < 8; ++j) { const float x1 = bf1(raw[d0][j]) * rp * gqp[i0 + j], x2 = bf1(raw[d0 + 2][j]) * rp * gqp[i0 + 32 + j]; const float c = tp[j], s = tp[32 + j];
                v1[j] = x1 * c - x2 * s; v2[j] = x1 * s + x2 * c; }
            qr[d0] = pack8(v1); qr[d0 + 2] = pack8(v2); }
}

struct AttnUnit { int qrow0, h, ntiles; const bf16_t* kv; const bf16_t* kpe; };
__device__ __forceinline__ void attn_unit(const Frame& F, const AttnUnit& U, const bf16_t* Q, const float* tab, const float* gqn, const float* gqp, bf16_t* mix) {
    int lane_; asm volatile("v_mbcnt_lo_u32_b32 %0, -1, 0\n\tv_mbcnt_hi_u32_b32 %0, -1, %0" : "=v"(lane_));
    const int lane = lane_, wid = F.wave, r32 = lane & 31, hi = lane >> 5;
    LAS unsigned char* lds = F.lds;
    constexpr int QF_OFF = 102400, KVT = 12800;
    {
        bf16x8 qr[12];
        load_q_frags(qr, Q, U.qrow0 + r32, U.h, hi, tab, gqn, gqp);
        if (wid == 0) {
#pragma unroll
            for (int d0 = 0; d0 < 12; ++d0) *(LAS bf16x8*)(lds + QF_OFF + d0 * 1024 + lane * 16) = qr[d0]; }
    }
    __syncthreads();
    f32x16 o[4];
#pragma unroll
    for (int d = 0; d < 4; ++d)
#pragma unroll
        for (int r = 0; r < 16; ++r) o[d][r] = 0.f;
    float m_reg = -1e30f, l_reg = 0.f;
    LAS unsigned char* vl = lds + wid * KVT;
    LAS float* aux = (LAS float*)(lds + AUX_OFF);
    LAS float* al_l = aux + 768 + wid * 32;
    const int vb = (int)(uintptr_t)vl + v_rd_base(lane);
    const bf16_t* kvh = U.kv + U.h * 256;
    bf16x8 kf[12], vr[8];
#define KLOAD(t_) do { const bf16_t* kp_ = kvh + (size_t)(32 * (t_) + (lane >> 4)) * 2048 + 8 * (lane & 15); const bf16_t* pp_ = U.kpe + (size_t)(32 * (t_) + (lane >> 3)) * 64 + 8 * (lane & 7); \
        _Pragma("unroll") for (int i_ = 0; i_ < 8; ++i_) kf[i_] = *(const bf16x8*)(kp_ + (size_t)(4 * i_) * 2048);        \
        _Pragma("unroll") for (int i_ = 0; i_ < 4; ++i_) kf[8 + i_] = *(const bf16x8*)(pp_ + (size_t)(8 * i_) * 64); } while (0)
#define KWRITE() do { _Pragma("unroll") for (int i_ = 0; i_ < 8; ++i_) *(LAS bf16x8*)(vl + (4 * i_ + (lane >> 4)) * 400 + 16 * (lane & 15)) = kf[i_]; \
        _Pragma("unroll") for (int i_ = 0; i_ < 4; ++i_) *(LAS bf16x8*)(vl + (8 * i_ + (lane >> 3)) * 400 + 256 + 16 * (lane & 7)) = kf[8 + i_]; } while (0)
    int t = wid;
    if (t < U.ntiles) { KLOAD(t); VT_LOAD(vr, kvh + (size_t)(32 * t) * 2048 + 128, 2048); }
    for (; t < U.ntiles; t += 8) {
        const int tn = t + 8;
        KWRITE();
        bf16x8 kq[12];
#pragma unroll
        for (int d0 = 0; d0 < 12; ++d0) kq[d0] = *(const LAS bf16x8*)(vl + r32 * 400 + 32 * d0 + 16 * hi);
        f32x16 p;
#pragma unroll
        for (int r = 0; r < 16; ++r) p[r] = 0.f;
#pragma unroll
        for (int d0 = 0; d0 < 12; ++d0) { const bf16x8 qf = *(const LAS bf16x8*)(lds + QF_OFF + d0 * 1024 + lane * 16); p = __builtin_amdgcn_mfma_f32_32x32x16_bf16(kq[d0], qf, p, 0, 0, 0); }
        if (tn < U.ntiles) KLOAD(tn);
        VT_WRITE(vl, vr);
        if (tn < U.ntiles) VT_LOAD(vr, kvh + (size_t)(32 * tn) * 2048 + 128, 2048);
        float pmax = p[0];
#pragma unroll
        for (int r = 1; r < 16; ++r) pmax = fmaxf(pmax, p[r]);
        pmax = xor32_max(pmax);
        const float mn = fmaxf(m_reg, pmax);
        const float alpha = __builtin_amdgcn_exp2f((m_reg - mn) * ATTN_C);
        m_reg = mn;
        const float mnC = mn * ATTN_C;
        float ps = 0.f;
#pragma unroll
        for (int r = 0; r < 16; ++r) { p[r] = __builtin_amdgcn_exp2f(fmaf(p[r], ATTN_C, -mnC)); ps += p[r]; }
        ps = xor32_sum(ps);
        l_reg = l_reg * alpha + ps;
        if (__any(alpha < 1.f)) {
            if (hi == 0) al_l[r32] = alpha;
            LDS_WAIT();
#pragma unroll
            for (int r = 0; r < 16; ++r) { const float a = al_l[crow(r, hi)];
#pragma unroll
                for (int d = 0; d < 4; ++d) o[d][r] *= a; }
        }
        bf16x8 pa0, pa1;
#define PK4(P, BASE, OUT) do { unsigned a0 = cvt_pk_bf16(P[BASE + 0], P[BASE + 1]), a1 = cvt_pk_bf16(P[BASE + 2], P[BASE + 3]);   \
    unsigned b0 = cvt_pk_bf16(P[BASE + 4], P[BASE + 5]), b1 = cvt_pk_bf16(P[BASE + 6], P[BASE + 7]);                              \
    auto r0 = __builtin_amdgcn_permlane32_swap(a0, b0, false, false); auto r1 = __builtin_amdgcn_permlane32_swap(a1, b1, false, false); \
    u32x4 w = {r0[0], r1[0], r0[1], r1[1]}; OUT = __builtin_bit_cast(bf16x8, w); } while (0)
        PK4(p, 0, pa0); PK4(p, 8, pa1);
#undef PK4
        pv32(o, vb, pa0, pa1);
    }
#undef KLOAD
#undef KWRITE
    if (hi == 0) { aux[wid * 32 + r32] = m_reg; aux[256 + wid * 32 + r32] = l_reg; }
    __syncthreads();
    float Mx = -1e30f;
#pragma unroll
    for (int w = 0; w < 8; ++w) Mx = fmaxf(Mx, aux[w * 32 + r32]);
    float L = 0.f;
#pragma unroll
    for (int w = 0; w < 8; ++w) L += aux[256 + w * 32 + r32] * __builtin_amdgcn_exp2f((aux[w * 32 + r32] - Mx) * ATTN_C);
    const float sc = __builtin_amdgcn_exp2f((m_reg - Mx) * ATTN_C) / L;
    if (hi == 0) aux[512 + wid * 32 + r32] = sc;
    LDS_WAIT();
    LAS float* ob = (LAS float*)lds + wid * 4096;
#pragma unroll
    for (int r = 0; r < 16; ++r) { const int row = crow(r, hi); const float a = aux[512 + wid * 32 + row];
#pragma unroll
        for (int d = 0; d < 4; ++d) ob[row * 128 + 32 * d + r32] = o[d][r] * a; }
    __syncthreads();
    {
        const int tid = wid * 64 + lane, row = tid >> 4, c8 = (tid & 15) * 8;
        f32x4 s0 = {0.f, 0.f, 0.f, 0.f}, s1 = {0.f, 0.f, 0.f, 0.f};
#pragma unroll
        for (int w = 0; w < 8; ++w) { const LAS f32x4* pw = (const LAS f32x4*)((LAS float*)lds + w * 4096 + row * 128 + c8); s0 += pw[0]; s1 += pw[1]; }
        float v[8] = {s0.x, s0.y, s0.z, s0.w, s1.x, s1.y, s1.z, s1.w};
        *(bf16x8*)(mix + (size_t)(U.qrow0 + row) * 2048 + 1024 + U.h * 128 + c8) = pack8(v);
    }
    __syncthreads();
}

constexpr int AT_VPM = 12;
constexpr int AT_KP = 400, AT_K = 0, AT_V = 64 * AT_KP, AT_BUF = AT_V + 16384;
__device__ __forceinline__ void attn_unit128(const Frame& F, int h, int qb4, const bf16_t* Q, const bf16_t* kv, const bf16_t* kpe, const float* tab, const float* gqn, const float* gqp, bf16_t* mix) {
    int lane_; asm volatile("v_mbcnt_lo_u32_b32 %0, -1, 0\n\tv_mbcnt_hi_u32_b32 %0, -1, %0" : "=v"(lane_));
    const int lane = lane_, wid = F.wave, r32 = lane & 31, hi = lane >> 5, qs = wid & 3, kg = wid >> 2, tid = wid * 64 + lane;
    LAS unsigned char* lds = F.lds;
    const int q0 = 128 * qb4, nst = 2 * qb4 + 2, mylast = 2 * qb4 + (qs >> 1);
    bf16x8 qr[12];
    load_q_frags(qr, Q, q0 + 32 * qs + r32, h, hi, tab, gqn, gqp);
    f32x16 o[4];
#pragma unroll
    for (int d = 0; d < 4; ++d)
#pragma unroll
        for (int r = 0; r < 16; ++r) o[d][r] = 0.f;
    float m_reg = -1e30f, l_reg = 0.f;
    LAS float* aux = (LAS float*)(lds + AUX_OFF);
    LAS float* al_l = aux + 768 + wid * 32;
    const bf16_t* kvh = kv + h * 256;
    const int vrow = tid >> 4, vcc = tid & 15;
    const int prow = tid >> 3, pcc = tid & 7;
    const unsigned vdst = (unsigned)(AT_V + v_st(vrow, 8 * vcc)), kdst = (unsigned)(AT_K + vrow * AT_KP + 16 * vcc), pdst = (unsigned)(AT_K + prow * AT_KP + 256 + 16 * pcc);
    bf16x8 sr[5];
#define AT_LOAD(j_) do { const bf16_t* b_ = kvh + (size_t)(64 * (j_)) * 2048; \
        sr[0] = *(const bf16x8*)(b_ + (size_t)vrow * 2048 + 128 + 8 * vcc); sr[1] = *(const bf16x8*)(b_ + (size_t)(vrow + 32) * 2048 + 128 + 8 * vcc); \
        sr[2] = *(const bf16x8*)(b_ + (size_t)vrow * 2048 + 8 * vcc); sr[3] = *(const bf16x8*)(b_ + (size_t)(vrow + 32) * 2048 + 8 * vcc); \
        sr[4] = *(const bf16x8*)(kpe + (size_t)(64 * (j_) + prow) * 64 + 8 * pcc); } while (0)
#define AT_WRITE(b_) do { LAS unsigned char* s_ = lds + (b_) * AT_BUF; \
        *(LAS bf16x8*)(s_ + vdst) = sr[0]; *(LAS bf16x8*)(s_ + vdst + 8192) = sr[1]; \
        *(LAS bf16x8*)(s_ + kdst) = sr[2]; *(LAS bf16x8*)(s_ + kdst + 32 * AT_KP) = sr[3]; *(LAS bf16x8*)(s_ + pdst) = sr[4]; } while (0)
    AT_LOAD(0); AT_WRITE(0);
    __syncthreads();
    const int kro = AT_K + (32 * kg + r32) * AT_KP + 16 * hi;
    const int vbb = (int)(uintptr_t)lds + AT_V + kg * 8192 + v_rd_base(lane);
    VFrags VF;
#pragma unroll
    for (int i = 0; i < 16; ++i) VF.f[i] = (s16x4){0, 0, 0, 0};
    bf16x8 pa0 = {0, 0, 0, 0, 0, 0, 0, 0}, pa1 = {0, 0, 0, 0, 0, 0, 0, 0};
    for (int j = 0; j < nst; ++j) {
        const int b = j & 1;
        if (j + 1 < nst) AT_LOAD(j + 1);
        if (j <= mylast) {
            const LAS unsigned char* ks = lds + b * AT_BUF + kro;
            f32x16 p;
#pragma unroll
            for (int r = 0; r < 16; ++r) p[r] = 0.f;
            { bf16x8 ka[4], kb[4];
#pragma unroll
              for (int d0 = 0; d0 < 4; ++d0) ka[d0] = *(const LAS bf16x8*)(ks + 32 * d0);
#pragma unroll
              for (int d0 = 0; d0 < 4; ++d0) kb[d0] = *(const LAS bf16x8*)(ks + 32 * (4 + d0));
              SBAR();
#pragma unroll
              for (int d0 = 0; d0 < 4; ++d0) p = __builtin_amdgcn_mfma_f32_32x32x16_bf16(ka[d0], qr[d0], p, 0, 0, 0);
              SBAR();
#pragma unroll
              for (int d0 = 0; d0 < 4; ++d0) ka[d0] = *(const LAS bf16x8*)(ks + 32 * (8 + d0));
              SBAR();
#pragma unroll
              for (int d0 = 0; d0 < 4; ++d0) p = __builtin_amdgcn_mfma_f32_32x32x16_bf16(kb[d0], qr[4 + d0], p, 0, 0, 0);
              SBAR();
#pragma unroll
              for (int d0 = 0; d0 < 4; ++d0) p = __builtin_amdgcn_mfma_f32_32x32x16_bf16(ka[d0], qr[8 + d0], p, 0, 0, 0); }
            asm volatile("s_waitcnt lgkmcnt(0)" ::: "memory"); SBAR();
            pv_mma(o, VF, pa0, pa1);
            float pmax = p[0];
#pragma unroll
            for (int r = 1; r < 16; ++r) pmax = fmaxf(pmax, p[r]);
            pmax = xor32_max(pmax);
            const float mn = fmaxf(m_reg, pmax);
            const float alpha = __builtin_amdgcn_exp2f((m_reg - mn) * ATTN_C);
            m_reg = mn;
            const float mnC = mn * ATTN_C;
            float ps = 0.f;
#pragma unroll
            for (int r = 0; r < 16; ++r) { p[r] = __builtin_amdgcn_exp2f(fmaf(p[r], ATTN_C, -mnC)); ps += p[r]; }
            ps = xor32_sum(ps);
            l_reg = l_reg * alpha + ps;
            bf16x8 na0, na1;
#define PK4(P, BASE, OUT) do { unsigned a0 = cvt_pk_bf16(P[BASE + 0], P[BASE + 1]), a1 = cvt_pk_bf16(P[BASE + 2], P[BASE + 3]);   \
    unsigned b0 = cvt_pk_bf16(P[BASE + 4], P[BASE + 5]), b1 = cvt_pk_bf16(P[BASE + 6], P[BASE + 7]);                              \
    auto r0 = __builtin_amdgcn_permlane32_swap(a0, b0, false, false); auto r1 = __builtin_amdgcn_permlane32_swap(a1, b1, false, false); \
    u32x4 w = {r0[0], r1[0], r0[1], r1[1]}; OUT = __builtin_bit_cast(bf16x8, w); } while (0)
            PK4(p, 0, na0); PK4(p, 8, na1);
#undef PK4
#pragma unroll
            for (int i = 0; i < 8; ++i) { __builtin_amdgcn_sched_group_barrier(0x008, 1, 0); __builtin_amdgcn_sched_group_barrier(0x002, AT_VPM, 0); }
            SBAR();
            pv_load(VF, vbb + b * AT_BUF);
            if (__any(alpha < 1.f)) {
                if (hi == 0) al_l[r32] = alpha;
                LDS_WAIT();
#pragma unroll
                for (int r = 0; r < 16; ++r) { const float a = al_l[crow(r, hi)];
#pragma unroll
                    for (int d = 0; d < 4; ++d) o[d][r] *= a; }
            }
            pa0 = na0; pa1 = na1;
        }
        if (j + 1 < nst) AT_WRITE(b ^ 1);
        __syncthreads();
    }
    asm volatile("s_waitcnt lgkmcnt(0)" ::: "memory"); SBAR();
    pv_mma(o, VF, pa0, pa1);
#undef AT_LOAD
#undef AT_WRITE
    if (hi == 0) { aux[wid * 32 + r32] = m_reg; aux[256 + wid * 32 + r32] = l_reg; }
    __syncthreads();
    const int pw = wid ^ 4;
    const float mo = aux[pw * 32 + r32], lo = aux[256 + pw * 32 + r32];
    const float Mx = fmaxf(m_reg, mo);
    const float es = __builtin_amdgcn_exp2f((m_reg - Mx) * ATTN_C), eo = __builtin_amdgcn_exp2f((mo - Mx) * ATTN_C);
    const float sc = es / (l_reg * es + lo * eo);
    if (hi == 0) aux[512 + wid * 32 + r32] = sc;
    LDS_WAIT();
    LAS float* ob = (LAS float*)lds + wid * 4096;
#pragma unroll
    for (int r = 0; r < 16; ++r) { const int row = crow(r, hi); const float a = aux[512 + wid * 32 + row];
#pragma unroll
        for (int d = 0; d < 4; ++d) ob[row * 128 + 32 * d + r32] = o[d][r] * a; }
    __syncthreads();
    {
        int l2 = lane; asm volatile("" : "+v"(l2)); const int te = wid * 64 + l2;
        const int row = te >> 2, seg = (te & 3) * 32, w0 = row >> 5, rr = row & 31;
        const LAS f32x4* pa = (const LAS f32x4*)((LAS float*)lds + w0 * 4096 + rr * 128 + seg);
        const LAS f32x4* pb = (const LAS f32x4*)((LAS float*)lds + (w0 + 4) * 4096 + rr * 128 + seg);
        bf16_t* dst = mix + (size_t)(q0 + row) * 2048 + 1024 + h * 128 + seg;
#pragma unroll
        for (int q = 0; q < 4; ++q) { const f32x4 x0 = pa[2 * q] + pb[2 * q], x1 = pa[2 * q + 1] + pb[2 * q + 1];
            float v[8] = {x0.x, x0.y, x0.z, x0.w, x1.x, x1.y, x1.z, x1.w}; *(bf16x8*)(dst + 8 * q) = pack8(v); }
    }
    __syncthreads();
}

__device__ __forceinline__ void gate_item(const Frame& F, int row0, int arow0, int jrow0, int ntj, int g, int c0, const bf16_t* wsg, const float* bsg, const float* SSV, const float* gv, const bf16_t* ZU, bf16_t* US, float* OVS) {
    const int lane = F.lane, r32 = lane & 31, hi = lane >> 5;
    LAS unsigned char* vl = F.lds + F.wave * 8192;
    const int vb = (int)(uintptr_t)vl + v_rd_base(lane);
    bf16x8 vr[8];
    VT_LOAD(vr, ZU + (size_t)jrow0 * 4096 + 2048 + c0, 4096);
    LAS float* rt = (LAS float*)(F.lds + 135168 + F.wave * 512);
    for (int rr = lane; rr < 32 * ntj; rr += 64) { const f32x4* sp = (const f32x4*)(SSV + (size_t)(jrow0 + rr) * 32); f32x4 t = sp[0];
#pragma unroll
        for (int k = 1; k < 8; ++k) t += sp[k];
        rt[rr] = rsq(((t.x + t.y) + (t.z + t.w)) * (1.f / GATE) + EPS); }
    const f32x4 gv0 = *(const f32x4*)(gv + c0 + (lane & 15) * 8), gv1 = *(const f32x4*)(gv + c0 + (lane & 15) * 8 + 4);
    f32x16 o[4];
#pragma unroll
    for (int d = 0; d < 4; ++d)
#pragma unroll
        for (int r = 0; r < 16; ++r) o[d][r] = 0.f;
    for (int jt = 0; jt < ntj; ++jt) {
#pragma unroll
        for (int it = 0; it < 8; ++it) { const float r = rt[32 * jt + 4 * it + (lane >> 4)]; const u32x4 w = __builtin_bit_cast(u32x4, vr[it]);
            float v[8] = {bflo(w.x), bfhi(w.x), bflo(w.y), bfhi(w.y), bflo(w.z), bfhi(w.z), bflo(w.w), bfhi(w.w)};
            v[0] *= r * gv0.x; v[1] *= r * gv0.y; v[2] *= r * gv0.z; v[3] *= r * gv0.w; v[4] *= r * gv1.x; v[5] *= r * gv1.y; v[6] *= r * gv1.z; v[7] *= r * gv1.w;
            vr[it] = pack8(v);
            if (OVS) { float* ov = OVS + (size_t)(32 * jt + 4 * it + (lane >> 4)) * GATE + c0 + (lane & 15) * 8;
                *(f32x4*)ov = (f32x4){v[0], v[1], v[2], v[3]}; *(f32x4*)(ov + 4) = (f32x4){v[4], v[5], v[6], v[7]}; } }
        const bf16_t* ap = wsg + (size_t)(arow0 + r32) * 128 + 32 * jt + 8 * hi;
        const bf16x8 pa0 = *(const bf16x8*)ap, pa1 = *(const bf16x8*)(ap + 16);
        VT_WRITE(vl, vr);
        if (jt + 1 < ntj) VT_LOAD(vr, ZU + (size_t)(jrow0 + 32 * (jt + 1)) * 4096 + 2048 + c0, 4096);
        pv32(o, vb, pa0, pa1);
    }
    LAS float* T = (LAS float*)(F.lds + 65536 + F.wave * 8704);
    u32x4 uu[2][4];
#pragma unroll
    for (int p = 0; p < 2; ++p)
#pragma unroll
        for (int k = 0; k < 4; ++k) { const int idx = lane + 64 * k; uu[p][k] = *(const u32x4*)(ZU + (size_t)(row0 + 16 * p + (idx >> 4)) * 4096 + c0 + 8 * (idx & 15)); }
#pragma unroll
    for (int p = 0; p < 2; ++p) {
#pragma unroll
        for (int rr = 0; rr < 8; ++rr) { const int r = 8 * p + rr, lr = (rr & 3) + 8 * (rr >> 2) + 4 * hi; const float b = bsg[arow0 + 16 * p + lr];
#pragma unroll
            for (int d = 0; d < 4; ++d) T[lr * 136 + 32 * d + r32] = o[d][r] + b; }
#pragma unroll
        for (int k = 0; k < 4; ++k) { const int idx = lane + 64 * k, row = idx >> 4, c8 = idx & 15;
            const f32x4 x0 = *(const LAS f32x4*)(T + row * 136 + 8 * c8), x1 = *(const LAS f32x4*)(T + row * 136 + 8 * c8 + 4); const u32x4 w = uu[p][k];
            float v[8] = {bflo(w.x) * x0.x, bfhi(w.x) * x0.y, bflo(w.y) * x0.z, bfhi(w.y) * x0.w, bflo(w.z) * x1.x, bfhi(w.z) * x1.y, bflo(w.w) * x1.z, bfhi(w.w) * x1.w};
            *(bf16x8*)(US + (size_t)(row0 + 16 * p + row) * 2048 + c0 + 8 * c8) = pack8(v); }
    }
}

#define CONVERT_RANGE(A_, B_, RANK_, NW_) do { \
    LAS float* scr_ = (LAS float*)(F.lds + F.wave * 16640); \
    int ra_ = (A_); asm volatile("" : "+s"(ra_));        \
    const int rb_ = (B_), st_ = (NW_); int it_ = ra_ + (RANK_), base_ = 0; \
    _Pragma("unroll 1") for (int q_ = 0; q_ < 44 && base_ < rb_; ++q_) { \
        const int L_ = q_ < 14 ? 0 : (q_ < 22 ? 1 : (q_ < 36 ? 2 : 3)), r_ = q_ - (q_ < 14 ? 0 : (q_ < 22 ? 14 : (q_ < 36 ? 22 : 36))), e_ = L_ >> 1, odd_ = L_ & 1; \
        const int nmix_ = odd_ ? 2 : 8; \
        const float* W_; bf16_t* WT_; const float* gk_ = nullptr; int K_, N_, mode_ = 0, off_ = 0; \
        if (r_ < 3 || r_ >= 3 + nmix_) { const int f_ = r_ < 3 ? 0 : 1, t_ = r_ < 3 ? r_ : r_ - 3 - nmix_; \
            if (t_ < 2) { W_ = INP((f_ ? 11 : 8) + t_) + (size_t)L_ * DM * FF; WT_ = (bf16_t*)(ws + WS_WGU + (size_t)(L_ * 2 + f_) * SZ_WGU); K_ = DM; N_ = FF; mode_ = 1; off_ = 128 * t_; gk_ = INP(f_ ? 7 : 5) + (size_t)L_ * DM; } \
            else { W_ = INP(f_ ? 13 : 10) + (size_t)L_ * FF * DM; WT_ = (bf16_t*)(ws + WS_WD + (size_t)(L_ * 2 + f_) * SZ_WD); K_ = FF; N_ = DM; } } \
        else if (!odd_) { const int m_ = r_ - 3; \
            if (m_ == 0) { W_ = INP(14) + (size_t)e_ * DM * EVIN; WT_ = (bf16_t*)(ws + WS_EWIN + e_ * SZ_EWIN); K_ = DM; N_ = EVIN; gk_ = INP(6) + (size_t)L_ * DM; } \
            else if (m_ == 1) { W_ = INP(17) + (size_t)e_ * QL * 1536; WT_ = (bf16_t*)(ws + WS_EWQB + e_ * SZ_EWQB); K_ = QL; N_ = 1536; } \
            else if (m_ == 2) { W_ = INP(18) + (size_t)e_ * KVL * 2048; WT_ = (bf16_t*)(ws + WS_EWKVB + e_ * SZ_EWKVB); K_ = KVL; N_ = 2048; } \
            else if (m_ < 7) { const int g_ = m_ - 3; W_ = INP(23) + (size_t)(e_ * 4 + g_) * 256 * 256; WT_ = (bf16_t*)(ws + WS_EPOOLW + e_ * SZ_EPOOLW); K_ = 256; N_ = 256; off_ = g_ * 256; } \
            else { W_ = INP(25) + (size_t)e_ * 2048 * 2048; WT_ = (bf16_t*)(ws + WS_EWOUT + e_ * SZ_SQ); K_ = 2048; N_ = 2048; } } \
        else { const int m_ = r_ - 3; \
            if (m_ == 0) { W_ = INP(26) + (size_t)e_ * DM * 4096; WT_ = (bf16_t*)(ws + WS_OWIN + e_ * SZ_OWIN); K_ = DM; N_ = 4096; gk_ = INP(6) + (size_t)L_ * DM; } \
            else { W_ = INP(30) + (size_t)e_ * 2048 * 2048; WT_ = (bf16_t*)(ws + WS_OWOUT + e_ * SZ_SQ); K_ = 2048; N_ = 2048; } } \
        const int nitems_ = (K_ / 64) * (N_ / 64); \
        const int end_ = (base_ + nitems_ < rb_) ? base_ + nitems_ : rb_; \
        if (it_ < end_) { \
            const RmAny rm_{mode_, off_}; \
            f32x4 vA_[16], vB_[16]; \
            _Pragma("unroll") for (int z_ = 0; z_ < 16; ++z_) vB_[z_] = (f32x4){0.f, 0.f, 0.f, 0.f};        \
            tr_load(vA_, W_, N_, it_ - base_, F.lane); \
            if (it_ + st_ < end_) tr_load(vB_, W_, N_, it_ + st_ - base_, F.lane); \
            while (it_ < end_) { \
                tr_to_lds(vA_, scr_, F.lane); \
                if (it_ + 2 * st_ < end_) tr_load(vA_, W_, N_, it_ + 2 * st_ - base_, F.lane); \
                tr_emit(K_, N_, WT_, rm_, scr_, it_ - base_, F.lane, gk_); \
                it_ += st_; \
                if (it_ >= end_) break; \
                tr_to_lds(vB_, scr_, F.lane); \
                if (it_ + 2 * st_ < end_) tr_load(vB_, W_, N_, it_ + 2 * st_ - base_, F.lane); \
                tr_emit(K_, N_, WT_, rm_, scr_, it_ - base_, F.lane, gk_); \
                it_ += st_; \
            } } \
        base_ += nitems_; \
    } } while (0)

template <int U> __device__ __forceinline__ void cache_convert(const float* src, bf16_t* dst, int W, size_t i0, size_t i1, int rank, int nthr) {
    const size_t per = (size_t)PAST * W, dper = (size_t)LKS * W;
    for (size_t b = i0 + rank; b < i1; b += (size_t)U * nthr) {
        f32x4 x0[U], x1[U];
#pragma unroll
        for (int u = 0; u < U; ++u) { const size_t i = b + (size_t)u * nthr; if (i < i1) { x0[u] = __builtin_nontemporal_load((const f32x4*)(src + i * 8)); x1[u] = __builtin_nontemporal_load((const f32x4*)(src + i * 8 + 4)); } }
#pragma unroll
        for (int u = 0; u < U; ++u) { const size_t i = b + (size_t)u * nthr; if (i < i1) { const size_t el = i * 8; const int s = (int)(el / per); const size_t rem = el - (size_t)s * per;
            float v[8] = {x0[u].x, x0[u].y, x0[u].z, x0[u].w, x1[u].x, x1[u].y, x1[u].z, x1[u].w}; *(bf16x8*)(dst + (size_t)s * dper + rem) = pack8(v); } }
    }
}

constexpr int LAST_SID = 1 + 11 * 8 + 3;
__global__ void __launch_bounds__(NTHR, 2) fwd(Args a) {
    extern __shared__ __attribute__((aligned(16))) unsigned char lds_raw[];
    LAS unsigned char* const LDSP = (LAS unsigned char*)lds_raw;
    const int wave0 = __builtin_amdgcn_readfirstlane((int)threadIdx.x >> 6);
    volatile LAS unsigned* MISC = (volatile LAS unsigned*)(LDSP + MISC_OFF);
    if (threadIdx.x < 64) MISC[threadIdx.x] = 0u;
    __syncthreads();
    unsigned char* const ws0 = a.ws;
    const bool one_launch = (a.hi - a.lo) > 1;
    XcdBarrier bar; bar.bar = (unsigned*)(ws0 + WS_CTL) + CW_BAR; bar.x = 0; bar.st = nullptr;
    if (one_launch) bar = xcd_barrier_post((unsigned*)(ws0 + WS_CTL) + CW_BAR, MISC + 8);
#define SITE_PTRS GAS unsigned char* ws_ = (GAS unsigned char*)ws0; asm volatile("" : "+s"(ws_)); unsigned char* const ws = (unsigned char*)ws_; GAS float* X_ = (GAS float*)a.out; asm volatile("" : "+s"(X_)); float* const X = (float*)X_;     \
    float* const tab = (float*)(ws + WS_TAB); bf16_t* const H = (bf16_t*)(ws + WS_H); bf16_t* const PART = (bf16_t*)(ws + WS_PART); bf16_t* const XB = (bf16_t*)(ws + WS_XB); (void)XB; float* const RS = (float*)(ws + WS_H); (void)RS; float* const SSP = (float*)(ws + WS_H + 65536); (void)SSP;        (void)tab; (void)H; (void)PART;
#define IN(s) (a.lo <= (s) && (s) < a.hi)
#define EVT(k) ((unsigned*)(ws + WS_CTL) + CW_EVT + 64 * (17 * (k)))
#define EVX(k) ((unsigned*)(ws + WS_CTL) + CW_EVT + 64 * (17 * (k) + 1 + (int)bar.x))
#define GATE(k) Gate{EVT(k), (unsigned)F.G, (unsigned*)(ws + WS_CTL) + CW_BAR + XB_TMO, one_launch ? bar.st : nullptr, -1, 32}
#define GATE_K(k, t) Gate{EVT(k), (unsigned)F.G, (unsigned*)(ws + WS_CTL) + CW_BAR + XB_TMO, one_launch ? bar.st : nullptr, (t), 1 << 30}
#define ARRIVE(k) do { if (one_launch) evt_arrive(EVT(k), EVX(k), threadIdx.x == 0 ? bar.st[0] : 0u); else evt_arrive(EVT(k), nullptr, 0u); } while (0)
#define SEAM(s) do { if (one_launch && (s) != LAST_SID) xcd_barrier(bar); } while (0)

    if (EN_PRO && IN(0)) { SITE_PTRS const Frame F = make_frame(LDSP, wave0); const int gtid = F.vcu * NTHR + F.tid, GT = F.G * NTHR; (void)gtid; (void)GT;
        if (PRO_MASK & 2) for (int idx = gtid; idx < M * 32; idx += GT) { const int row = idx >> 5, i = idx & 31; const int pos = row < MP ? row : PAST + ((row - MP) & 31);
            const float inv = __builtin_amdgcn_exp2f(-(float)i * (13.287712379549449f / 32.f));
            const double rev = (double)pos * (double)inv * 0.15915494309189535; const float fr = (float)(rev - __builtin_rint(rev));
            tab[(size_t)row * 64 + i] = __builtin_amdgcn_cosf(fr); tab[(size_t)row * 64 + 32 + i] = __builtin_amdgcn_sinf(fr); }
        cache_convert<4>(INP(2), (bf16_t*)(ws + WS_CKVS), KVL, 0, (size_t)DB * PAST * KVL / 8, gtid, GT);
        cache_convert<4>(INP(3), (bf16_t*)(ws + WS_KPES), ROPE, 0, (size_t)DB * PAST * ROPE / 8, gtid, GT);
        if (PRO_MASK & 8) for (int o = 0; o < 2; ++o) { const float* src = INP(28) + (size_t)o * 8 * 128 * 128; bf16_t* dst = (bf16_t*)(ws + WS_OWS + o * SZ_OWS);
            for (int idx = gtid; idx < 8 * 128 * 128; idx += GT) { const int j = idx & 127, i = (idx >> 7) & 127; dst[idx] = f2bf(j <= i ? src[idx] : 0.f); } }
        if (PRO_MASK & 8) for (int e = 0; e < 2; ++e) { u32x4* d = (u32x4*)(ws + WS_EWIN + e * SZ_EWIN + (size_t)EVIN * DM * 2);
            for (int i = gtid; i < (EVINP - EVIN) * DM * 2 / 16; i += GT) d[i] = (u32x4){0u, 0u, 0u, 0u}; }
#pragma unroll 1
        for (int rg = 0; rg < 12; ++rg) { const int ra = a.plan[24 + 2 * rg], rb = a.plan[25 + 2 * rg]; if (ra < rb) CONVERT_RANGE(ra, rb, F.gw, F.NGW); }
        stat_pass(F, XB, RS, PART, 0.f, INP(0), INP(1), SSP);
        SEAM(0);
    }

    for (int L = 0; L < DEPTH; ++L) {
        for (int part = 0; part < 3; ++part) {
            const int sb = 1 + (L * 3 + part) * 8;
            if (part != 1) {
                const int f = part >> 1;
                if (EN_FFN && IN(sb + 0) && !(L == 0 && part == 0)) { SITE_PTRS const Frame F = make_frame(LDSP, wave0); const int gtid = F.vcu * NTHR + F.tid, GT = F.G * NTHR; (void)gtid; (void)GT; if (F.G == 256) stat_pass2(F, XB, RS, PART, part == 0 ? 0.5f : 1.0f, SSP); else stat_pass(F, XB, RS, PART, part == 0 ? 0.5f : 1.0f, nullptr, nullptr, SSP); ARRIVE(L * 3 + part); }
                if (EN_FFN && IN(sb + 1)) { SITE_PTRS const Frame F = make_frame(LDSP, wave0); const int gtid = F.vcu * NTHR + F.tid, GT = F.G * NTHR; (void)gtid; (void)GT;
                    pg8::Gemm g{XB, (const bf16_t*)(ws + WS_WGU + (size_t)(L * 2 + f) * SZ_WGU), M, 2 * FF, DM, DM, DM, 0};
                    pg8::StaticOrder S; S.init(M, 2 * FF, F.G, (int)blockIdx.x, DM);
                    pg8::EpiSwiGLU E{(bf16_t*)(ws + WS_ACT), FF, RS, (LAS float*)(F.lds + AUX_OFF + 4096)};
                    pg8::gemm_phase<pg8::EpiSwiGLU, pg8::StaticOrder>(F.lds, g, S, E, F.tid, (L == 0 && part == 0) ? Gate{nullptr, 0u, nullptr, nullptr, -1, 32} : GATE(L * 3 + part));
                    { const int k = 3 * L + (part ? 2 : 0), c = (int)blockIdx.x;
                      if (c >= 48) CONVERT_RANGE(a.plan[k], a.plan[12 + k], (c - 48) * 8 + F.wave, 208 * 8); }
                    SEAM(sb + 1);
                }
                if (EN_FFN && IN(sb + 2)) { SITE_PTRS const Frame F = make_frame(LDSP, wave0); const int gtid = F.vcu * NTHR + F.tid, GT = F.G * NTHR; (void)gtid; (void)GT;
                    pg8::Gemm g{(const bf16_t*)(ws + WS_ACT), (const bf16_t*)(ws + WS_WD + (size_t)(L * 2 + f) * SZ_WD), M, DM, FF, FF, FF, 0};
                    pg8::SplitOrder S; S.init(DM, F.G, (int)blockIdx.x, FF);
                    pg8::EpiResid E{XB, DM, 0.5f, PART, FF / 64, (L == DEPTH - 1 && part == 2) ? X : nullptr, SSP};
                    pg8::gemm_phase<pg8::EpiResid, pg8::SplitOrder>(F.lds, g, S, E, F.tid);
                    SEAM(sb + 2);
                }
            } else {
                if (EN_FFN && IN(sb + 0)) { SITE_PTRS const Frame F = make_frame(LDSP, wave0); const int gtid = F.vcu * NTHR + F.tid, GT = F.G * NTHR; (void)gtid; (void)GT; if (F.G == 256) stat_pass2(F, XB, RS, PART, 0.5f, SSP); else stat_pass(F, XB, RS, PART, 0.5f, nullptr, nullptr, SSP); ARRIVE(L * 3 + 1); }
                const int e = L >> 1;
                if ((L & 1) == 0) {
#define Z ((float*)(ws + WS_Z))
#define POOLED ((bf16_t*)(ws + WS_POOLED))
#define QAN ((bf16_t*)(ws + WS_QAN))
#define Qb ((bf16_t*)(ws + WS_Q))
#define CKVP ((bf16_t*)(ws + WS_CKVP))
#define KPEP ((bf16_t*)(ws + WS_KPEP))
#define CKVS ((bf16_t*)(ws + WS_CKVS + e * SZ_CKVS))
#define KPES ((bf16_t*)(ws + WS_KPES + e * SZ_KPES))
#define KVP ((bf16_t*)(ws + WS_KVP))
#define KVS ((bf16_t*)(ws + WS_BIG))
#define MIX ((bf16_t*)(ws + WS_MIX))
                    if (EN_EVG && IN(sb + 1)) { SITE_PTRS const Frame F = make_frame(LDSP, wave0); const int gtid = F.vcu * NTHR + F.tid, GT = F.G * NTHR; (void)gtid; (void)GT;
                        pg8::Gemm g{XB, (const bf16_t*)(ws + WS_EWIN + e * SZ_EWIN), M, EVINP, DM, DM, DM, 0};
                        pg8::StaticOrder S; S.init(M, EVINP, F.G, (int)blockIdx.x, DM);
                        pg8::EpiF32 E{Z, EVINP, RS, (LAS float*)(F.lds + AUX_OFF + 4096)};
                        pg8::gemm_phase<pg8::EpiF32, pg8::StaticOrder>(F.lds, g, S, E, F.tid, GATE(L * 3 + 1));
                        { const int k = 3 * L + 1, c = (int)blockIdx.x; if (c >= 68) CONVERT_RANGE(a.plan[k], a.plan[12 + k], (c - 68) * 8 + F.wave, 188 * 8); }
                        SEAM(sb + 1);
                    }
                    if (EN_EVMID && IN(sb + 2)) { SITE_PTRS const Frame F = make_frame(LDSP, wave0); const int gtid = F.vcu * NTHR + F.tid, GT = F.G * NTHR; (void)gtid; (void)GT;
                        const float* gqa = INP(15) + e * QL; const float* gkva = INP(16) + e * KVL; const float* gkpe = INP(22) + e * ROPE;
                        for (int row = F.gw; row < M; row += 2 * F.NGW) {
                            const int row2 = row + F.NGW; const bool two = row2 < M; const int lane = F.lane;
                            f32x4 zq0[2], zq1[2], zk0[2], zk1[2]; float zp[2];
                            zq0[1] = zq1[1] = zk0[1] = zk1[1] = (f32x4){0.f, 0.f, 0.f, 0.f}; zp[1] = 0.f;
#pragma unroll
                            for (int q = 0; q < 2; ++q) if (q == 0 || two) { const float* zr = Z + (size_t)(q ? row2 : row) * EVINP;
                                zq0[q] = *(const f32x4*)(zr + 1024 + 8 * lane); zq1[q] = *(const f32x4*)(zr + 1028 + 8 * lane);
                                zk0[q] = *(const f32x4*)(zr + 1536 + 8 * lane); zk1[q] = *(const f32x4*)(zr + 1540 + 8 * lane); zp[q] = zr[2048 + lane]; }
                            const f32x4 ga0 = *(const f32x4*)(gqa + 8 * lane), ga1 = *(const f32x4*)(gqa + 8 * lane + 4), gb0 = *(const f32x4*)(gkva + 8 * lane), gb1 = *(const f32x4*)(gkva + 8 * lane + 4);
                            const float gpe = gkpe[lane];
#pragma unroll
                            for (int q = 0; q < 2; ++q) if (q == 0 || two) { const int rw = q ? row2 : row;
                                const f32x4 q0 = zq0[q], q1 = zq1[q], k0 = zk0[q], k1 = zk1[q]; const float pr = zp[q];
                                const float rq = rsq(wave_sum((q0.x * q0.x + q0.y * q0.y) + (q0.z * q0.z + q0.w * q0.w) + (q1.x * q1.x + q1.y * q1.y) + (q1.z * q1.z + q1.w * q1.w)) * (1.f / QL) + EPS);
                                const float rk = rsq(wave_sum((k0.x * k0.x + k0.y * k0.y) + (k0.z * k0.z + k0.w * k0.w) + (k1.x * k1.x + k1.y * k1.y) + (k1.z * k1.z + k1.w * k1.w)) * (1.f / KVL) + EPS);
                                const float rp = rsq(wave_sum(pr * pr) * (1.f / ROPE) + EPS);
                                { float v[8] = {q0.x * rq * ga0.x, q0.y * rq * ga0.y, q0.z * rq * ga0.z, q0.w * rq * ga0.w, q1.x * rq * ga1.x, q1.y * rq * ga1.y, q1.z * rq * ga1.z, q1.w * rq * ga1.w};
                                  *(bf16x8*)(QAN + (size_t)rw * QL + 8 * lane) = pack8(v); }
                                const f32x4 c0 = {k0.x * rk * gb0.x, k0.y * rk * gb0.y, k0.z * rk * gb0.z, k0.w * rk * gb0.w}, c1 = {k1.x * rk * gb1.x, k1.y * rk * gb1.y, k1.z * rk * gb1.z, k1.w * rk * gb1.w};
                                const float pn = pr * rp * gpe; const float other = xor32_other(pn, lane);
                                const float cs = tab[(size_t)rw * 64 + (lane & 31)], sn = tab[(size_t)rw * 64 + 32 + (lane & 31)];
                                const float pe = lane < 32 ? pn * cs - other * sn : other * sn + pn * cs;
                                float* oc; float* op; bf16_t* bc; bf16_t* bp;
                                if (rw < MP) { oc = X + O_CKVP + ((size_t)e * MP + rw) * KVL; op = X + O_KPEP + ((size_t)e * MP + rw) * ROPE; bc = CKVP + (size_t)rw * KVL; bp = KPEP + (size_t)rw * ROPE; }
                                else { const int sr = rw - MP, s = sr >> 5, i = sr & 31; oc = X + O_CKVS + ((size_t)e * MS + sr) * KVL; op = X + O_KPES + ((size_t)e * MS + sr) * ROPE;
                                       bc = CKVS + ((size_t)s * LKS + PAST + i) * KVL; bp = KPES + ((size_t)s * LKS + PAST + i) * ROPE; }
                                *(f32x4*)(oc + 8 * lane) = c0; *(f32x4*)(oc + 8 * lane + 4) = c1;
                                { float v[8] = {c0.x, c0.y, c0.z, c0.w, c1.x, c1.y, c1.z, c1.w}; *(bf16x8*)(bc + 8 * lane) = pack8(v); }
                                op[lane] = pe; bp[lane] = f2bf(pe);
                            }
                        }
                        const float* hist = INP(4) + (size_t)e * DB * 15 * POOLD;
                        for (int it = F.vcu; it < (M / 16) * 2; it += F.G) {
                            const int rb = it >> 1, col = (it & 1) * 512 + F.tid, gq = col >> 8;
                            const int row0 = rb * 16; const bool prm = row0 < MP;
                            const int seq0 = prm ? 0 : MP + ((row0 - MP) & ~31);
                            const int l0 = row0 - seq0; const int s = prm ? 0 : (row0 - MP) >> 5;
                            const float* hs = hist + (size_t)s * 15 * POOLD + col;
                            const float* zc = Z + (size_t)seq0 * EVINP + col; bf16_t* pc = POOLED + (size_t)seq0 * POOLD + col;
                            if (gq == 0) pool16<2>(zc, hs, pc, l0, prm); else if (gq == 1) pool16<4>(zc, hs, pc, l0, prm); else if (gq == 2) pool16<8>(zc, hs, pc, l0, prm); else pool16<16>(zc, hs, pc, l0, prm);
                        }
                        for (int idx = gtid; idx < 33 * 15 * POOLD; idx += GT) { const int col = idx & 1023, j = (idx >> 10) % 15, sq = idx / (15 * POOLD);
                            if (sq == 0) X[O_POOLP + ((size_t)e * 15 + j) * POOLD + col] = Z[(size_t)(MP - 15 + j) * EVINP + col];
                            else { const int s = sq - 1; X[O_POOLS + (((size_t)e * DB + s) * 15 + j) * POOLD + col] = Z[(size_t)(MP + 32 * s + 17 + j) * EVINP + col]; } }
                        SEAM(sb + 2);
                    }
                    if (EN_EVG && IN(sb + 3)) { SITE_PTRS const Frame F = make_frame(LDSP, wave0); const int gtid = F.vcu * NTHR + F.tid, GT = F.G * NTHR; (void)gtid; (void)GT;
                        { pg8::Gemm g{POOLED, (const bf16_t*)(ws + WS_EPOOLW + e * SZ_EPOOLW), M, 1024, 256, 1024, 256, 512};
                          pg8::StaticOrder S; S.init(M, 1024, F.G, (int)((blockIdx.x + 144) % F.G), 256);
                          pg8::EpiBf16<0> E{MIX, 2048, 0, INP(24) + e * POOLD, nullptr, nullptr, nullptr};
                          pg8::gemm_phase<pg8::EpiBf16<0>, pg8::StaticOrder>(F.lds, g, S, E, F.tid); }
                        { pg8::Gemm g{QAN, (const bf16_t*)(ws + WS_EWQB + e * SZ_EWQB), M, 1536, QL, QL, QL, 0};
                          pg8::StaticOrder S; S.init(M, 1536, F.G, (int)((blockIdx.x + 216) % F.G), QL);
                          pg8::EpiBf16<0> E{Qb, 1536, 0, nullptr, nullptr, nullptr, nullptr};
                          pg8::gemm_phase<pg8::EpiBf16<0>, pg8::StaticOrder>(F.lds, g, S, E, F.tid); }
                        { pg8::Gemm g{CKVP, (const bf16_t*)(ws + WS_EWKVB + e * SZ_EWKVB), MP, 2048, KVL, KVL, KVL, 0};
                          pg8::StaticOrder S; S.init(MP, 2048, F.G, (int)blockIdx.x, KVL);
                          pg8::EpiKV E{KVP, 2048, INP(21) + e * NOPE, (LAS float*)(F.lds + AUX_OFF)};
                          pg8::gemm_phase<pg8::EpiKV, pg8::StaticOrder>(F.lds, g, S, E, F.tid); }
                        { pg8::Gemm g{CKVS, (const bf16_t*)(ws + WS_EWKVB + e * SZ_EWKVB), MKS, 2048, KVL, KVL, KVL, 0};
                          pg8::StaticOrder S; S.init(MKS, 2048, F.G, (int)blockIdx.x, KVL);
                          pg8::EpiKV E{KVS, 2048, INP(21) + e * NOPE, (LAS float*)(F.lds + AUX_OFF)};
                          pg8::gemm_phase<pg8::EpiKV, pg8::StaticOrder>(F.lds, g, S, E, F.tid); }
                        SEAM(sb + 3);
                    }
                    if (EN_ATTN && IN(sb + 5)) { SITE_PTRS const Frame F = make_frame(LDSP, wave0); const int gtid = F.vcu * NTHR + F.tid, GT = F.G * NTHR; (void)gtid; (void)GT;
                        const float* gqn = INP(19) + e * NOPE; const float* gqp = INP(20) + e * ROPE;
                        const int sp = F.vcu % 3;
#pragma unroll 1
                        for (int ph = 0; ph < 3; ++ph) {
                            if (ph == sp) { AttnUnit U; const int s = F.vcu & 31; U.qrow0 = MP + 32 * s; U.h = F.vcu >> 5; U.ntiles = LKS / 32; U.kv = KVS + (size_t)s * LKS * 2048; U.kpe = KPES + (size_t)s * LKS * ROPE;
                                attn_unit(F, U, Qb, tab, gqn, gqp, MIX); }
                            else { const int half = ph - (ph > sp ? 1 : 0), pr = F.vcu & 31;
                                attn_unit128(F, F.vcu >> 5, half ? 63 - pr : pr, Qb, KVP, KPEP, tab, gqn, gqp, MIX); }
                            if (L == 0 && ph == 0) {
                                const size_t n1 = (size_t)DB * PAST * KVL / 8, n2 = (size_t)DB * PAST * ROPE / 8;
                                cache_convert<8>(INP(2) + (size_t)DB * PAST * KVL, (bf16_t*)(ws + WS_CKVS + SZ_CKVS), KVL, n1 * F.vcu / F.G, n1 * (F.vcu + 1) / F.G, F.tid, NTHR);
                                cache_convert<8>(INP(3) + (size_t)DB * PAST * ROPE, (bf16_t*)(ws + WS_KPES + SZ_KPES), ROPE, n2 * F.vcu / F.G, n2 * (F.vcu + 1) / F.G, F.tid, NTHR); }
                        }
                        ARRIVE(12 + e);
                    }
                    if (EN_EVG && IN(sb + 6)) { SITE_PTRS const Frame F = make_frame(LDSP, wave0); const int gtid = F.vcu * NTHR + F.tid, GT = F.G * NTHR; (void)gtid; (void)GT;
                        pg8::Gemm g{MIX, (const bf16_t*)(ws + WS_EWOUT + e * SZ_SQ), M, DM, 2048, 2048, 2048, 0};
                        pg8::SplitOrder S; S.init(DM, F.G, (int)blockIdx.x, 2048);
                        pg8::EpiResid E{XB, DM, 1.0f, PART, 2048 / 64, nullptr, SSP};
                        pg8::gemm_phase<pg8::EpiResid, pg8::SplitOrder>(F.lds, g, S, E, F.tid, GATE_K(12 + e, 14));
                        SEAM(sb + 6);
                    }
                } else {
#define ZO ((bf16_t*)(ws + WS_Z))
#define VN ((bf16_t*)(ws + WS_VN))
#define US ((bf16_t*)(ws + WS_US))
                    if (EN_ODDG && IN(sb + 1)) { SITE_PTRS const Frame F = make_frame(LDSP, wave0); const int gtid = F.vcu * NTHR + F.tid, GT = F.G * NTHR; (void)gtid; (void)GT;
                        pg8::Gemm g{XB, (const bf16_t*)(ws + WS_OWIN + e * SZ_OWIN), M, 4096, DM, DM, DM, 0};
                        pg8::StaticOrder S; S.init(M, 4096, F.G, (int)blockIdx.x, DM);
                        pg8::EpiBf16<1> E{ZO, 4096, 0, nullptr, RS, (LAS float*)(F.lds + AUX_OFF + 4096), (float*)(ws + WS_H + 2097152)};
                        pg8::gemm_phase<pg8::EpiBf16<1>, pg8::StaticOrder>(F.lds, g, S, E, F.tid, GATE(L * 3 + 1));
                        { const int k = 3 * L + 1, c = (int)blockIdx.x; if (c >= 64) CONVERT_RANGE(a.plan[k], a.plan[12 + k], (c - 64) * 8 + F.wave, 192 * 8); }
                        SEAM(sb + 1);
                    }
                    if (EN_GATE && IN(sb + 5)) { SITE_PTRS const Frame F = make_frame(LDSP, wave0); const int gtid = F.vcu * NTHR + F.tid, GT = F.G * NTHR; (void)gtid; (void)GT;
                        const bf16_t* wsb = (const bf16_t*)(ws + WS_OWS + e * SZ_OWS); const float* bs = INP(29) + (size_t)e * 8 * 128;
                        const float* SSV = (const float*)(ws + WS_H + 2097152); const float* gv = INP(27) + (size_t)e * GATE;
                        for (int id = F.gw; id < 64 * 8 * 2 * 2; id += F.NGW) {
                            const int k = id & 1, rest = id >> 1, ch = rest & 1, g = (rest >> 1) & 7, n = rest >> 4;
#pragma unroll 1
                            for (int half = 0; half < 2; ++half) { const int ib = half ? 3 - k : k;
                                gate_item(F, 128 * n + 32 * ib, 32 * ib, 128 * n, ib + 1, g, 256 * g + 128 * ch, wsb + (size_t)g * 128 * 128, bs + g * 128, SSV, gv, ZO, US, nullptr); }
                        }
                        for (int id = F.gw; id < DB * 8 * 2; id += F.NGW) {
                            const int ch = id & 1, g = (id >> 1) & 7, s = id >> 4;
                            gate_item(F, MP + 32 * s, 0, MP + 32 * s, 1, g, 256 * g + 128 * ch, wsb + (size_t)g * 128 * 128, bs + g * 128, SSV, gv, ZO, US, X + O_VS + ((size_t)e * MS + 32 * s) * GATE);
                        }
                        SEAM(sb + 5);
                    }
                    if (EN_ODDG && IN(sb + 6)) { SITE_PTRS const Frame F = make_frame(LDSP, wave0); const int gtid = F.vcu * NTHR + F.tid, GT = F.G * NTHR; (void)gtid; (void)GT;
                        pg8::Gemm g{US, (const bf16_t*)(ws + WS_OWOUT + e * SZ_SQ), M, DM, 2048, 2048, 2048, 0};
                        pg8::SplitOrder S; S.init(DM, F.G, (int)blockIdx.x, 2048);
                        pg8::EpiResid E{XB, DM, 1.0f, PART, 2048 / 64, nullptr, SSP};
                        pg8::gemm_phase<pg8::EpiResid, pg8::SplitOrder>(F.lds, g, S, E, F.tid);
                        SEAM(sb + 6);
                    }
                }
            }
        }
    }
    if (IN(LAST_SID)) { SITE_PTRS const Frame F = make_frame(LDSP, wave0);
        if (F.G == 256) {
            const int half = F.wave >> 2, row = MP + 4 * F.vcu + (F.wave & 3);
            const u32x4* xr = (const u32x4*)(XB + (size_t)row * DM + half * 1024) + F.lane; float* yr = X + (size_t)row * DM + half * 1024 + 8 * F.lane;
            const u32x4* pr = (const u32x4*)(PART + (size_t)(row - MP) * DM + half * 1024) + F.lane;
            u32x4 w[2], q[8][2];
#pragma unroll
            for (int j = 0; j < 2; ++j) w[j] = xr[64 * j];
#pragma unroll
            for (int sl = 0; sl < 8; ++sl)
#pragma unroll
                for (int j = 0; j < 2; ++j) q[sl][j] = pr[(size_t)sl * (1024 * 2048 / 8) + 64 * j];
#pragma unroll
            for (int j = 0; j < 2; ++j) { f32x4 t0 = {0.f, 0.f, 0.f, 0.f}, t1 = {0.f, 0.f, 0.f, 0.f};
#pragma unroll
                for (int sl = 0; sl < 8; ++sl) { t0 += bf4((u32x2){q[sl][j].x, q[sl][j].y}); t1 += bf4((u32x2){q[sl][j].z, q[sl][j].w}); }
                *(f32x4*)(yr + 512 * j) = bf4((u32x2){w[j].x, w[j].y}) + t0 * 0.5f; *(f32x4*)(yr + 512 * j + 4) = bf4((u32x2){w[j].z, w[j].w}) + t1 * 0.5f; }
        } else
        for (int row = MP + F.gw; row < M; row += F.NGW) {
            const u32x2* xr = (const u32x2*)(XB + (size_t)row * DM) + F.lane; f32x4* yr = (f32x4*)(X + (size_t)row * DM) + F.lane;
            const u32x2* pr = (const u32x2*)(PART + (size_t)(row - MP) * DM) + F.lane;
#pragma unroll
            for (int j = 0; j < 8; ++j) { f32x4 t = {0.f, 0.f, 0.f, 0.f};
#pragma unroll
                for (int sl = 0; sl < 8; ++sl) t += bf4(pr[(size_t)sl * (1024 * 2048 / 4) + 64 * j]);
                yr[64 * j] = bf4(xr[64 * j]) + t * 0.5f; }
        }
    }
#undef IN
#undef SEAM
#undef Z
#undef POOLED
#undef QAN
#undef Qb
#undef CKVP
#undef KPEP
#undef CKVS
#undef KPES
#undef KVP
#undef KVS
#undef MIX
#undef ZO
#undef VN
#undef US
}

extern "C" void kernel_launch(void* const* d_in, const int* in_sizes, int n_in, void* d_out, int out_size, void* d_ws, size_t ws_size, hipStream_t stream) {
    static int grid = 0;
    if (grid == 0) {
        if (n_in != 31 || out_size != (int)O_END || ws_size < WS_END) { fprintf(stderr, "kernel_launch: unexpected shapes: n_in %d out %d ws %zu (need %zu)\n", n_in, out_size, ws_size, (size_t)WS_END); grid = -1; return; }
        int dev = 0, cus = 0;
        if (hipGetDevice(&dev) != hipSuccess || hipDeviceGetAttribute(&cus, hipDeviceAttributeMultiprocessorCount, dev) != hipSuccess) { grid = -1; return; }
        if (hipFuncSetAttribute((const void*)fwd, hipFuncAttributeMaxDynamicSharedMemorySize, LDS_BYTES) != hipSuccess) { fprintf(stderr, "kernel_launch: hipFuncSetAttribute failed\n"); grid = -1; return; }
        int per_cu = 0; (void)hipOccupancyMaxActiveBlocksPerMultiprocessor(&per_cu, (const void*)fwd, NTHR, LDS_BYTES); (void)hipGetLastError();
        grid = cus;
        if (grid != 256) fprintf(stderr, "kernel_launch: %d CUs (built for 256)\n", grid);
    }
    if (grid < 0) return;
    (void)hipMemsetAsync((char*)d_ws + WS_CTL, 0, CTL_BYTES, stream);
    Args a{};
    for (int i = 0; i < 31; ++i) a.in[i] = (const float*)d_in[i];
    a.out = (float*)d_out; a.ws = (unsigned char*)d_ws;
    {
        static const int slot[12][2] = {{5632, 12288}, {12288, 18304}, {18304, 24960}, {25120, 31776}, {31776, 37920}, {37920, 44576}, {45088, 51744}, {51744, 57760}, {57760, 64416}, {64576, 71232}, {71232, 77376}, {77376, 78912}};
        static const int pro[12][2] = {{0, 5632}, {24960, 25120}, {44576, 45088}, {64416, 64576}, {0, 0}, {0, 0}, {0, 0}, {0, 0}, {0, 0}, {0, 0}, {0, 0}, {0, 0}};
        for (int k = 0; k < 12; ++k) { a.plan[k] = slot[k][0]; a.plan[12 + k] = slot[k][1]; a.plan[24 + 2 * k] = pro[k][0]; a.plan[25 + 2 * k] = pro[k][1]; } }
#if MK_PER_STEP
    for (int s = 0; s <= LAST_SID; ++s) {
        if (s > 0) { const int q = (s - 1) / 8, k = (s - 1) % 8, part = q % 3, L = q / 3;
            if (part != 1) { if (k > 2 && s != LAST_SID) continue; } else if ((L & 1) == 0) { if (k == 4 || k > 6) continue; } else { if (k == 2 || k == 3 || k == 4 || k > 6) continue; } }
        a.lo = s; a.hi = s + 1;
        hipLaunchKernelGGL(fwd, dim3(grid), dim3(NTHR), LDS_BYTES, stream, a);
    }
#else
    a.lo = 0; a.hi = LAST_SID + 1;
    hipLaunchKernelGGL(fwd, dim3(grid), dim3(NTHR), LDS_BYTES, stream, a);
#endif
    const hipError_t le = hipPeekAtLastError();
    if (le != hipSuccess) fprintf(stderr, "kernel_launch: launch failed: %s\n", hipGetErrorName(le));
}
```
